# Optimizing an MI355X kernel written in HIP

```python
import jax, jax.numpy as jnp
from jax import lax
import numpy as np

D_MODEL = 1024
BATCH = 32
SEQ = 256
DEPTH = 2
DEC_BATCH = 4
DEC_SEQ = 2048
PAST_LEN = 512

GRID_W = 64
N_EVEN = (DEPTH + 1) // 2
N_ODD = DEPTH // 2
EPS = 1e-6
H_RET = 4
DK_RET = D_MODEL // 8
DV_RET = 2 * DK_RET
RET_CHUNK = 128
POOL_WINDOWS = (2, 4, 8, 16)
N_POOL_GROUPS = 4
POOL_WIDTH = D_MODEL // 2
POOL_GROUP_DIM = POOL_WIDTH // N_POOL_GROUPS
EVEN_IN = 2 * H_RET * DK_RET + 2 * H_RET * DV_RET + POOL_WIDTH
EVEN_MIX = H_RET * DV_RET + POOL_WIDTH
HEAD_DIM = 128
N_HEADS = D_MODEL // HEAD_DIM
KV_HEADS = 2
Q_BLOCK = 128
ROPE_BASE = 10000.0
ROPE_PAIRS = HEAD_DIM // 4
QKV_OUT = (N_HEADS + 2 * KV_HEADS) * HEAD_DIM
D_FF = -(-8 * D_MODEL // (3 * 256)) * 256

kernel_name = "hybrid_retpool_gqa_diffusion_step"


def rmsnorm(x, gain):
    x32 = x.astype(jnp.float32)
    y = x32 * lax.rsqrt(jnp.mean(x32 * x32, axis=-1, keepdims=True) + EPS)
    return y.astype(x.dtype) * gain


def swiglu(h, w_in, w_out):
    a, b = jnp.split(h @ w_in, 2, axis=-1)
    return (jax.nn.silu(a) * b) @ w_out


def retention_chunked(q, k, v, log_gamma, s0):
    B, T, H, DK = q.shape
    DV = v.shape[-1]
    nc = T // RET_CHUNK
    dt = q.dtype
    n = jnp.arange(RET_CHUNK, dtype=jnp.float32)
    diff = n[:, None] - n[None, :]
    dmask = jnp.where(diff[None] >= 0, jnp.exp(jnp.maximum(diff, 0.0)[None] * log_gamma[:, None, None]), 0.0).astype(dt)
    xi = jnp.exp((n + 1.0)[:, None] * log_gamma[None, :]).astype(dt)
    zeta = jnp.exp((RET_CHUNK - 1.0 - n)[:, None] * log_gamma[None, :]).astype(dt)
    chunk_decay = jnp.exp(RET_CHUNK * log_gamma).astype(dt)

    def to_chunks(a):
        return a.reshape(B, nc, RET_CHUNK, H, a.shape[-1]).transpose(1, 0, 2, 3, 4)

    def step(s, inp):
        qc, kc, vc = inp
        scores = jnp.einsum('bnhd,bmhd->bhnm', qc, kc) * dmask[None]
        inner = jnp.einsum('bhnm,bmhe->bnhe', scores, vc)
        cross = jnp.einsum('bnhd,bhde->bnhe', qc * xi[None, :, :, None], s)
        s_new = s * chunk_decay[None, :, None, None] + jnp.einsum('bmhd,bmhe->bhde', kc * zeta[None, :, :, None], vc)
        return s_new, inner + cross

    s_fin, out = lax.scan(step, s0.astype(dt), (to_chunks(q), to_chunks(k), to_chunks(v)))
    out = out.transpose(1, 0, 2, 3, 4).reshape(B, T, H, DV)
    return out, s_fin


def multiscale_pool(u, pool_w, pool_scale):
    B, T, _ = u.shape
    ug = u.reshape(B, T, N_POOL_GROUPS, POOL_GROUP_DIM)
    csum = jnp.cumsum(ug.astype(jnp.float32), axis=1)
    P = jnp.concatenate([jnp.zeros((B, 1, N_POOL_GROUPS, POOL_GROUP_DIM), jnp.float32), csum], axis=1)
    half = jnp.array([w // 2 for w in POOL_WINDOWS], jnp.int32)
    t = jnp.arange(T, dtype=jnp.int32)
    lo = jnp.clip(t[:, None] - half[None, :], 0, T)
    hi = jnp.clip(t[:, None] + half[None, :], 0, T)
    gidx = jnp.arange(N_POOL_GROUPS, dtype=jnp.int32)[None, :]
    cnt = (hi - lo).astype(jnp.float32)[None, :, :, None]
    mean = (P[:, hi, gidx, :] - P[:, lo, gidx, :]) / cnt
    d = mean.astype(u.dtype) - ug
    out = jnp.einsum('btgc,gcd->btgd', d, pool_w).reshape(B, T, POOL_WIDTH)
    return out * pool_scale


def ret_pool_mixer(h, w_in, decay_logit, gn_gain, pool_w, pool_scale, w_out, s0_f, s0_b):
    B, T, _ = h.shape
    proj = h @ w_in
    sizes = np.cumsum([H_RET * DK_RET, H_RET * DK_RET, H_RET * DV_RET, H_RET * DV_RET])
    q, k, v, g, u = jnp.split(proj, [int(s) for s in sizes], axis=-1)
    q = q.reshape(B, T, H_RET, DK_RET) * (DK_RET ** -0.5)
    k = k.reshape(B, T, H_RET, DK_RET)
    v = v.reshape(B, T, H_RET, DV_RET)
    lg = jax.nn.log_sigmoid(decay_logit.astype(jnp.float32))
    o_f, s_f = retention_chunked(q, k, v, lg[0], s0_f)
    o_b, s_b = retention_chunked(q[:, ::-1], k[:, ::-1], v[:, ::-1], lg[1], s0_b)
    y = (o_f + o_b[:, ::-1]).astype(jnp.float32)
    mu = jnp.mean(y, axis=-1, keepdims=True)
    var = jnp.mean(jnp.square(y - mu), axis=-1, keepdims=True)
    y = ((y - mu) * lax.rsqrt(var + EPS)).astype(h.dtype).reshape(B, T, H_RET * DV_RET) * gn_gain
    ret_out = jax.nn.silu(g) * y
    pool_out = multiscale_pool(u, pool_w, pool_scale)
    out = jnp.concatenate([ret_out, pool_out], axis=-1) @ w_out
    return out, s_f, s_b


def axial_rope(x):
    T = x.shape[1]
    rows = T // GRID_W
    r = jnp.repeat(jnp.arange(rows, dtype=jnp.float32), GRID_W)
    cl = jnp.tile(jnp.arange(GRID_W, dtype=jnp.float32), rows)
    freqs = ROPE_BASE ** (-jnp.arange(ROPE_PAIRS, dtype=jnp.float32) / ROPE_PAIRS)

    def rot(xh, pos):
        ang = pos[:, None] * freqs[None, :]
        cos = jnp.cos(ang).astype(x.dtype)[None, :, None, :]
        sin = jnp.sin(ang).astype(x.dtype)[None, :, None, :]
        x1, x2 = xh[..., :ROPE_PAIRS], xh[..., ROPE_PAIRS:]
        return jnp.concatenate([x1 * cos - x2 * sin, x2 * cos + x1 * sin], axis=-1)

    hd2 = HEAD_DIM // 2
    return jnp.concatenate([rot(x[..., :hd2], r), rot(x[..., hd2:], cl)], axis=-1)


def block_attention(q, k, v):
    B, S, _, D = q.shape
    G = N_HEADS // KV_HEADS
    nb = S // Q_BLOCK
    qb = q.reshape(B, nb, Q_BLOCK, KV_HEADS, G, D).transpose(1, 0, 2, 3, 4, 5)
    scale = HEAD_DIM ** -0.5

    def one_block(qblk):
        s = jnp.einsum('bqkgd,btkd->bkgqt', qblk, k).astype(jnp.float32) * scale
        p = jax.nn.softmax(s, axis=-1).astype(v.dtype)
        return jnp.einsum('bkgqt,btkd->bqkgd', p, v)

    out = lax.map(one_block, qb)
    return out.transpose(1, 0, 2, 3, 4, 5).reshape(B, S, N_HEADS * D)


def attn_project(h, w_qkv, q_gain, k_gain):
    B, T, _ = h.shape
    q, k, v = jnp.split(h @ w_qkv, [N_HEADS * HEAD_DIM, (N_HEADS + KV_HEADS) * HEAD_DIM], axis=-1)
    q = rmsnorm(q.reshape(B, T, N_HEADS, HEAD_DIM), q_gain)
    k = rmsnorm(k.reshape(B, T, KV_HEADS, HEAD_DIM), k_gain)
    v = v.reshape(B, T, KV_HEADS, HEAD_DIM)
    return q, k, v


def setup_inputs(seed: int = 0) -> dict:
    key = jax.random.key(seed)
    ks = jax.random.split(key, 24)
    nrm = lambda k, shape, s: jax.random.normal(k, shape, jnp.float32) * s
    base_gamma = 1.0 - 2.0 ** (-5.0 - jnp.arange(H_RET, dtype=jnp.float32))
    base_logit = jnp.log(base_gamma / (1.0 - base_gamma))
    return {
        "x_prompt": nrm(ks[0], (BATCH, SEQ, D_MODEL), 1.0),
        "x_sample": nrm(ks[1], (DEC_BATCH, DEC_SEQ, D_MODEL), 1.0),
        "state_ret": nrm(ks[2], (DEC_BATCH, N_EVEN, 2, H_RET, DK_RET, DV_RET), 0.5),
        "cache_k": nrm(ks[3], (DEC_BATCH, N_ODD, PAST_LEN, KV_HEADS, HEAD_DIM), 1.0),
        "cache_v": nrm(ks[4], (DEC_BATCH, N_ODD, PAST_LEN, KV_HEADS, HEAD_DIM), 1.0),
        "c": nrm(ks[5], (DEC_BATCH, D_MODEL), 1.0),
        "c_ctx": nrm(ks[6], (D_MODEL,), 1.0),
        "w_ada": nrm(ks[7], (DEPTH, D_MODEL, 6 * D_MODEL), 0.5 * D_MODEL ** -0.5),
        "b_ada": nrm(ks[8], (DEPTH, 6 * D_MODEL), 0.02),
        "norm_gain": 1.0 + nrm(ks[9], (DEPTH, 4, D_MODEL), 0.05),
        "w_ffn_in": nrm(ks[10], (DEPTH, D_MODEL, 2 * D_FF), D_MODEL ** -0.5),
        "w_ffn_out": nrm(ks[11], (DEPTH, D_FF, D_MODEL), D_FF ** -0.5),
        "w_in_even": nrm(ks[12], (N_EVEN, D_MODEL, EVEN_IN), D_MODEL ** -0.5),
        "ret_decay_logit": base_logit[None, None, :] + nrm(ks[13], (N_EVEN, 2, H_RET), 0.1),
        "ret_gn_gain": 1.0 + nrm(ks[14], (N_EVEN, H_RET * DV_RET), 0.05),
        "pool_w": nrm(ks[15], (N_EVEN, N_POOL_GROUPS, POOL_GROUP_DIM, POOL_GROUP_DIM), POOL_GROUP_DIM ** -0.5),
        "pool_scale": 1.0 + nrm(ks[16], (N_EVEN, POOL_WIDTH), 0.1),
        "w_out_even": nrm(ks[17], (N_EVEN, EVEN_MIX, D_MODEL), EVEN_MIX ** -0.5),
        "w_qkv": nrm(ks[18], (N_ODD, D_MODEL, QKV_OUT), D_MODEL ** -0.5),
        "q_norm_gain": 1.0 + nrm(ks[19], (N_ODD, HEAD_DIM), 0.05),
        "k_norm_gain": 1.0 + nrm(ks[20], (N_ODD, HEAD_DIM), 0.05),
        "w_o": nrm(ks[21], (N_ODD, N_HEADS * HEAD_DIM, D_MODEL), (N_HEADS * HEAD_DIM) ** -0.5),
    }


def reference(x_prompt, x_sample, state_ret, cache_k, cache_v, c, c_ctx, w_ada, b_ada, norm_gain,
              w_ffn_in, w_ffn_out, w_in_even, ret_decay_logit, ret_gn_gain, pool_w, pool_scale,
              w_out_even, w_qkv, q_norm_gain, k_norm_gain, w_o):
    xp, xs = x_prompt, x_sample
    new_ret, new_k, new_v = [], [], []
    for i in range(DEPTH):
        j = i // 2
        mod_p = (jax.nn.silu(c_ctx)[None, :] @ w_ada[i] + b_ada[i])[:, None, :]
        mod_s = (jax.nn.silu(c) @ w_ada[i] + b_ada[i])[:, None, :]
        sh1p, sc1p, g1p, sh2p, sc2p, g2p = jnp.split(mod_p, 6, axis=-1)
        sh1s, sc1s, g1s, sh2s, sc2s, g2s = jnp.split(mod_s, 6, axis=-1)
        hp = rmsnorm(xp, norm_gain[i, 0]) * (1.0 + sc1p) + sh1p
        hs = rmsnorm(xs, norm_gain[i, 0]) * (1.0 + sc1s) + sh1s
        if i % 2 == 0:
            zeros = jnp.zeros((xp.shape[0], H_RET, DK_RET, DV_RET), xp.dtype)
            op, sf, sb = ret_pool_mixer(hp, w_in_even[j], ret_decay_logit[j], ret_gn_gain[j], pool_w[j],
                                        pool_scale[j], w_out_even[j], zeros, zeros)
            new_ret.append(jnp.stack([sf, sb], axis=1))
            os_, _, _ = ret_pool_mixer(hs, w_in_even[j], ret_decay_logit[j], ret_gn_gain[j], pool_w[j],
                                       pool_scale[j], w_out_even[j], state_ret[:, j, 0], state_ret[:, j, 1])
        else:
            qp, kp, vp = attn_project(hp, w_qkv[j], q_norm_gain[j], k_norm_gain[j])
            op = block_attention(qp, kp, vp) @ w_o[j]
            new_k.append(kp)
            new_v.append(vp)
            qs, ksl, vs = attn_project(hs, w_qkv[j], q_norm_gain[j], k_norm_gain[j])
            qs, ksl = axial_rope(qs), axial_rope(ksl)
            k_all = jnp.concatenate([cache_k[:, j], ksl], axis=1)
            v_all = jnp.concatenate([cache_v[:, j], vs], axis=1)
            os_ = block_attention(qs, k_all, v_all) @ w_o[j]
        xp = xp + g1p * rmsnorm(op, norm_gain[i, 1])
        xs = xs + g1s * rmsnorm(os_, norm_gain[i, 1])
        fp = swiglu(rmsnorm(xp, norm_gain[i, 2]) * (1.0 + sc2p) + sh2p, w_ffn_in[i], w_ffn_out[i])
        fs = swiglu(rmsnorm(xs, norm_gain[i, 2]) * (1.0 + sc2s) + sh2s, w_ffn_in[i], w_ffn_out[i])
        xp = xp + g2p * rmsnorm(fp, norm_gain[i, 3])
        xs = xs + g2s * rmsnorm(fs, norm_gain[i, 3])
    new_state_ret = jnp.stack(new_ret, axis=1)
    new_cache_k = jnp.stack(new_k, axis=1)
    new_cache_v = jnp.stack(new_v, axis=1)
    return (xp, xs, new_state_ret, new_cache_k, new_cache_v)
```

```cpp
#include <hip/hip_runtime.h>
#include <hip/hip_bf16.h>
#include <cstdio>
#include <cstdint>
#include <cmath>
namespace pg8 {
#define PG8_LAS __attribute__((address_space(3)))
typedef unsigned short bf16_t;
typedef short bf16x8 __attribute__((ext_vector_type(8)));
typedef float f32x4 __attribute__((ext_vector_type(4)));
typedef unsigned u32x4 __attribute__((ext_vector_type(4)));
constexpr int BM = 256, BK = 64, HALF = 128, HTB = HALF * BK * 2  , STAGE_BYTES = 8 * HTB, NXCD = 8, WGM = 8;

__host__ __device__ __forceinline__ int lds_byte(int r, int c) { const int st = (r >> 4) * 2 + (c >> 5), rr = r & 15, cc = c & 31, ob = rr * 64 + cc * 2; return st * 1024 + (ob ^ (((ob >> 9) & 1) << 5)); }
__host__ __device__ __forceinline__ void stage_rc(int b, int& R, int& C) { const int st = b / 1024, sb = b % 1024, swz = sb ^ (((sb >> 9) & 1) << 5); R = (st >> 1) * 16 + swz / 64; C = (st & 1) * 32 + (swz % 64) / 2; }
__host__ __device__ __forceinline__ int perm32(int rho) { const int n = rho >> 4, i = rho & 15; return 8 * (i >> 2) + 4 * n + (i & 3); }

struct Unit { int pm, pn; };
struct Gemm { const bf16_t* A; const bf16_t* Bt; int M, N, K; };

struct StaticOrder {
    int nM, nN, nwg, G, c;
    __host__ __device__ void init(int M, int N, int G_, int c_) { nM = M / BM; nN = N / BM; nwg = nM * nN; G = G_; c = c_; }
    __host__ __device__ bool next(int i, Unit& u) const {
        const long L = (long)i * G + c; if (L >= nwg) return false;
        int wgid = (int)L; { const int q = nwg / NXCD, r = nwg % NXCD, xcd = wgid % NXCD, off = wgid / NXCD; wgid = (xcd < r ? xcd * (q + 1) : r * (q + 1) + (xcd - r) * q) + off; }
        const int nig = WGM * nN, gid = wgid / nig, fm = gid * WGM, gsz = (nM - fm) < WGM ? (nM - fm) : WGM;
        u.pm = fm + ((wgid % nig) % gsz); u.pn = (wgid % nig) / gsz; return true;
    }
    __device__ __forceinline__ void a_ready(const Unit&) const {}
    __device__ __forceinline__ void done(const Unit&) const {}
};

__device__ __forceinline__ unsigned cvt_pk_bf16(float lo, float hi) { unsigned r; asm volatile("v_cvt_pk_bf16_f32 %0, %1, %2" : "=v"(r) : "v"(lo), "v"(hi)); return r; }

struct EpiBf16P {
    static constexpr bool PERM = true, AFTER_DRAIN = false;
    bf16_t* O; int ldc;
    __device__ __forceinline__ void operator()(const f32x4 (&acc)[2][2][4][2], const Unit& u, int wr, int wc, int fr, int fq) const {
        const int row0 = u.pm * BM + wr * 64 + fr, col0 = u.pn * BM + wc * 32 + 8 * fq;
#pragma unroll
        for (int ai = 0; ai < 2; ++ai)
#pragma unroll
            for (int m = 0; m < 4; ++m) { bf16_t* rowp = O + (size_t)(row0 + ai * HALF + m * 16) * ldc + col0;
#pragma unroll
                for (int bj = 0; bj < 2; ++bj) { const f32x4 v0 = acc[ai][bj][m][0], v1 = acc[ai][bj][m][1];
                    u32x4 w; w.x = cvt_pk_bf16(v0[0], v0[1]); w.y = cvt_pk_bf16(v0[2], v0[3]); w.z = cvt_pk_bf16(v1[0], v1[1]); w.w = cvt_pk_bf16(v1[2], v1[3]);
                    *(u32x4*)(rowp + bj * HALF) = w; } }
    }
};

struct EpiF32 {
    static constexpr bool PERM = false, AFTER_DRAIN = false;
    float* C; int ldc;
    __device__ __forceinline__ void operator()(const f32x4 (&acc)[2][2][4][2], const Unit& u, int wr, int wc, int fr, int fq) const {
        const int row0 = u.pm * BM + wr * 64 + fr, col0 = u.pn * BM + wc * 32 + 4 * fq;
#pragma unroll
        for (int ai = 0; ai < 2; ++ai)
#pragma unroll
            for (int m = 0; m < 4; ++m) { float* rowp = C + (size_t)(row0 + ai * HALF + m * 16) * ldc + col0;
#pragma unroll
                for (int bj = 0; bj < 2; ++bj)
#pragma unroll
                    for (int n = 0; n < 2; ++n) *(f32x4*)(rowp + bj * HALF + n * 16) = acc[ai][bj][m][n]; }
    }
};

__device__ __forceinline__ float silu_f(float a) { return a * __builtin_amdgcn_rcpf(1.0f + __builtin_amdgcn_exp2f(-1.4426950408889634f * a)); }

struct EpiSwiGLU {
    static constexpr bool PERM = true, AFTER_DRAIN = false;
    bf16_t* O; int ldc;
    __device__ __forceinline__ void operator()(const f32x4 (&acc)[2][2][4][2], const Unit& u, int wr, int wc, int fr, int fq) const {
        const int row0 = u.pm * BM + wr * 64 + fr, col0 = u.pn * HALF + wc * 32 + 8 * fq;
#pragma unroll
        for (int ai = 0; ai < 2; ++ai)
#pragma unroll
            for (int m = 0; m < 4; ++m) { bf16_t* rowp = O + (size_t)(row0 + ai * HALF + m * 16) * ldc + col0;
                const f32x4 a0 = acc[ai][0][m][0], a1 = acc[ai][0][m][1], b0 = acc[ai][1][m][0], b1 = acc[ai][1][m][1];
                u32x4 w; w.x = cvt_pk_bf16(silu_f(a0[0]) * b0[0], silu_f(a0[1]) * b0[1]); w.y = cvt_pk_bf16(silu_f(a0[2]) * b0[2], silu_f(a0[3]) * b0[3]);
                w.z = cvt_pk_bf16(silu_f(a1[0]) * b1[0], silu_f(a1[1]) * b1[1]); w.w = cvt_pk_bf16(silu_f(a1[2]) * b1[2], silu_f(a1[3]) * b1[3]);
                *(u32x4*)rowp = w; }
    }
};
template <class Epi, class Sched, bool ALIGN_EPI = false, bool SP2 = false>
__device__ __forceinline__ void gemm_phase(PG8_LAS unsigned char* lds, const Gemm g, const Sched& S, const Epi& E) {
    const int tid = threadIdx.x, wid = __builtin_amdgcn_readfirstlane(tid >> 6), lane = tid & 63, wr = wid >> 2, wc = wid & 3, fr = lane & 15, fq = lane >> 4;
    const int K = g.K, nt = K / BK;
    unsigned voffA[2], voffB[2];
#pragma unroll
    for (int i = 0; i < 2; ++i) { int R, C; stage_rc(tid * 16 + i * 8192, R, C); const int Rb = Epi::PERM ? ((R & ~31) + perm32(R & 31)) : R;
        voffA[i] = (unsigned)(R * K + C) * 2u; voffB[i] = (unsigned)(Rb * K + C) * 2u; }
    const size_t kstep = (size_t)(BK * 2);
    const size_t hstep = (size_t)HALF * K * 2;
    const size_t tstep = 2 * hstep;
    const unsigned ldsw = (unsigned)wid * 1024u;
    const int aoff = lds_byte(wr * 64 + fr, fq * 8), boff = lds_byte(wc * 32 + fr, fq * 8);
#define PG8_SA(b, h) (((b) * 2 + (h)) * HTB)
#define PG8_SB(b, h) ((4 + (b) * 2 + (h)) * HTB)
#define PG8_STAGE(bufoff, gbase, voff) do { _Pragma("unroll") for (int _i = 0; _i < 2; ++_i) \
        __builtin_amdgcn_global_load_lds((const unsigned*)((const char*)(gbase) + (voff)[_i]), (PG8_LAS unsigned*)(lds + (bufoff) + ldsw + _i * 8192), 16, 0, 0); } while (0)
#define PG8_LDA(dst, b, h) do { _Pragma("unroll") for (int m = 0; m < 4; ++m) _Pragma("unroll") for (int k = 0; k < 2; ++k) dst[m][k] = *(const PG8_LAS bf16x8*)(lds + PG8_SA(b, h) + aoff + m * 2048 + k * 1024); } while (0)
#define PG8_LDB(dst, b, h) do { _Pragma("unroll") for (int n = 0; n < 2; ++n) _Pragma("unroll") for (int k = 0; k < 2; ++k) dst[n][k] = *(const PG8_LAS bf16x8*)(lds + PG8_SB(b, h) + boff + n * 2048 + k * 1024); } while (0)
#define PG8_MMA(ai, bj, At, Bt) do { __builtin_amdgcn_s_setprio(1); _Pragma("unroll") for (int m = 0; m < 4; ++m) _Pragma("unroll") for (int n = 0; n < 2; ++n) _Pragma("unroll") for (int k = 0; k < 2; ++k) \
        acc[ai][bj][m][n] = __builtin_amdgcn_mfma_f32_16x16x32_bf16(Bt[n][k], At[m][k], acc[ai][bj][m][n], 0, 0, 0); __builtin_amdgcn_s_setprio(0); } while (0)
#define PG8_WAIT_V(n) asm volatile("s_waitcnt vmcnt(" #n ")" ::: "memory")
#define PG8_WAIT_L(n) asm volatile("s_waitcnt lgkmcnt(" #n ")" ::: "memory")
#define PG8_BAR __builtin_amdgcn_s_barrier()
#define PG8_SCHED __builtin_amdgcn_sched_barrier(0)
    Unit cur, nxt; int ui = 0;
    if (!S.next(0, cur)) return;
    f32x4 acc[2][2][4][2];
#pragma unroll
    for (int a = 0; a < 2; ++a)
#pragma unroll
        for (int b = 0; b < 2; ++b)
#pragma unroll
            for (int m = 0; m < 4; ++m)
#pragma unroll
                for (int n = 0; n < 2; ++n) acc[a][b][m][n] = (f32x4){0.f, 0.f, 0.f, 0.f};
    bf16x8 At[4][2], B0[2][2], B1[2][2];
    const char* cA = (const char*)g.A + (size_t)cur.pm * tstep; const char* cB = (const char*)g.Bt + (size_t)cur.pn * tstep;
    S.a_ready(cur);
    if constexpr (SP2) {
        PG8_STAGE(PG8_SB(0, 0), cB, voffB); PG8_STAGE(PG8_SB(0, 1), cB + hstep, voffB); PG8_STAGE(PG8_SA(0, 0), cA, voffA); PG8_STAGE(PG8_SA(0, 1), cA + hstep, voffA);
        if (wr == 1) PG8_BAR;
        PG8_WAIT_V(2); PG8_BAR;
        PG8_STAGE(PG8_SB(1, 0), cB + kstep, voffB); PG8_STAGE(PG8_SA(1, 0), cA + kstep, voffA); PG8_STAGE(PG8_SB(1, 1), cB + hstep + kstep, voffB);
        PG8_WAIT_V(6); PG8_BAR;
    } else {
        PG8_STAGE(PG8_SB(0, 0), cB, voffB); PG8_STAGE(PG8_SA(0, 0), cA, voffA); PG8_STAGE(PG8_SB(0, 1), cB + hstep, voffB); PG8_STAGE(PG8_SA(0, 1), cA + hstep, voffA);
        if (wr == 1) PG8_BAR;
        PG8_WAIT_V(4); PG8_BAR;
        PG8_STAGE(PG8_SB(1, 0), cB + kstep, voffB); PG8_STAGE(PG8_SA(1, 0), cA + kstep, voffA); PG8_STAGE(PG8_SB(1, 1), cB + hstep + kstep, voffB);
        PG8_WAIT_V(6); PG8_BAR;
    }
    for (;;) {
        const bool has_next = S.next(ui + 1, nxt);
        const char* nA = has_next ? (const char*)g.A + (size_t)nxt.pm * tstep : cA; const char* nB = has_next ? (const char*)g.Bt + (size_t)nxt.pn * tstep : cB;
        for (int t = 0; t < nt; t += 2) {
            const bool last = (t == nt - 2);
            const char* a1 = cA + (size_t)(t + 1) * kstep;
            const char* a2 = last ? nA : cA + (size_t)(t + 2) * kstep; const char* b2 = last ? nB : cB + (size_t)(t + 2) * kstep;
            const char* a3 = a2 + kstep; const char* b3 = b2 + kstep;
            if (last && has_next) S.a_ready(nxt);
            if constexpr (SP2) {
            PG8_LDB(B0, 0, 0); PG8_LDB(B1, 0, 1); PG8_SCHED; PG8_LDA(At, 0, 0); PG8_STAGE(PG8_SA(1, 1), a1 + hstep, voffA);
            PG8_WAIT_V(8); PG8_WAIT_L(0); PG8_BAR; PG8_MMA(0, 0, At, B0); PG8_MMA(0, 1, At, B1); PG8_BAR; PG8_SCHED;
            PG8_LDA(At, 0, 1); PG8_STAGE(PG8_SB(0, 0), b2, voffB); PG8_STAGE(PG8_SB(0, 1), b2 + hstep, voffB); PG8_STAGE(PG8_SA(0, 0), a2, voffA);
            PG8_WAIT_V(8); PG8_WAIT_L(0); PG8_BAR; PG8_MMA(1, 0, At, B0); PG8_MMA(1, 1, At, B1); PG8_BAR; PG8_SCHED;
            PG8_LDB(B0, 1, 0); PG8_LDB(B1, 1, 1); PG8_SCHED; PG8_LDA(At, 1, 0); PG8_STAGE(PG8_SA(0, 1), a2 + hstep, voffA);
            PG8_WAIT_V(8); PG8_WAIT_L(0); PG8_BAR; PG8_MMA(0, 0, At, B0); PG8_MMA(0, 1, At, B1); PG8_BAR; PG8_SCHED;
            PG8_LDA(At, 1, 1); PG8_STAGE(PG8_SB(1, 0), b3, voffB); PG8_STAGE(PG8_SB(1, 1), b3 + hstep, voffB); PG8_STAGE(PG8_SA(1, 0), a3, voffA);
            PG8_WAIT_V(8); PG8_WAIT_L(0); PG8_BAR; PG8_MMA(1, 0, At, B0); PG8_MMA(1, 1, At, B1); PG8_BAR; PG8_SCHED;
            } else {
            PG8_LDB(B0, 0, 0); PG8_SCHED; PG8_LDA(At, 0, 0); PG8_STAGE(PG8_SA(1, 1), a1 + hstep, voffA);
            PG8_WAIT_L(8); PG8_BAR; PG8_WAIT_L(0); PG8_MMA(0, 0, At, B0); PG8_BAR; PG8_SCHED;
            PG8_LDB(B1, 0, 1); PG8_STAGE(PG8_SB(0, 0), b2, voffB);
            PG8_BAR; PG8_WAIT_L(0); PG8_MMA(0, 1, At, B1); PG8_BAR;
            PG8_LDA(At, 0, 1); PG8_STAGE(PG8_SA(0, 0), a2, voffA);
            PG8_BAR; PG8_WAIT_L(0); PG8_MMA(1, 0, At, B0); PG8_BAR; PG8_SCHED;
            PG8_STAGE(PG8_SB(0, 1), b2 + hstep, voffB);
            PG8_WAIT_V(6); PG8_BAR; PG8_MMA(1, 1, At, B1); PG8_BAR;
            PG8_LDB(B0, 1, 0); PG8_SCHED; PG8_LDA(At, 1, 0); PG8_STAGE(PG8_SA(0, 1), a2 + hstep, voffA);
            PG8_WAIT_L(8); PG8_BAR; PG8_WAIT_L(0); PG8_MMA(0, 0, At, B0); PG8_BAR; PG8_SCHED;
            PG8_LDB(B1, 1, 1); PG8_STAGE(PG8_SB(1, 0), b3, voffB);
            PG8_BAR; PG8_WAIT_L(0); PG8_MMA(0, 1, At, B1); PG8_BAR;
            PG8_LDA(At, 1, 1); PG8_STAGE(PG8_SA(1, 0), a3, voffA);
            PG8_BAR; PG8_WAIT_L(0); PG8_MMA(1, 0, At, B0); PG8_BAR; PG8_SCHED;
            PG8_STAGE(PG8_SB(1, 1), b3 + hstep, voffB);
            PG8_WAIT_V(6); PG8_BAR; PG8_MMA(1, 1, At, B1); PG8_BAR;
            }
        }
        if constexpr (ALIGN_EPI) { if (wr == 0) PG8_BAR; }
        if constexpr (!Epi::AFTER_DRAIN) { E(acc, cur, wr, wc, fr, fq); S.done(cur); }
        if (!has_next) break;
#pragma unroll
        for (int a = 0; a < 2; ++a)
#pragma unroll
            for (int b = 0; b < 2; ++b)
#pragma unroll
                for (int m = 0; m < 4; ++m)
#pragma unroll
                    for (int n = 0; n < 2; ++n) acc[a][b][m][n] = (f32x4){0.f, 0.f, 0.f, 0.f};
        cur = nxt; cA = nA; cB = nB; ++ui;
        if constexpr (ALIGN_EPI) { if (wr == 1) PG8_BAR; }
    }
    PG8_WAIT_V(0);
    if constexpr (!ALIGN_EPI) { if (wr == 0) PG8_BAR; }
    PG8_BAR;
    if constexpr (Epi::AFTER_DRAIN) { E.fused(acc, cur, wr, wc, fr, fq, lds, wid, lane); S.done(cur); }
#undef PG8_SA
#undef PG8_SB
#undef PG8_STAGE
#undef PG8_LDA
#undef PG8_LDB
#undef PG8_MMA
#undef PG8_WAIT_V
#undef PG8_WAIT_L
#undef PG8_BAR
#undef PG8_SCHED
}
}
namespace att {
using bf16 = __hip_bfloat16;
constexpr int D = 128, NW = 8, QBLK = 32, KVBLK = 64;
constexpr float SCALE = 0.088388347648318440f;
constexpr float THR = 8.f;
constexpr int SDEPTH = 2;
constexpr int LDQ = 1024, LDK = 256, LDO = 1024;
constexpr size_t SHM_V = KVBLK * D * 2, SHM_K = KVBLK * D * 2, SHM_ATTN = 2 * SHM_V + 2 * SHM_K + NW * 64 * 4;
using bf16x8 = __attribute__((ext_vector_type(8))) short;
using s16x4  = __attribute__((ext_vector_type(4))) short;
using f32x16 = __attribute__((ext_vector_type(16))) float;
using f32x8  = __attribute__((ext_vector_type(8))) float;
using u32x4  = __attribute__((ext_vector_type(4))) unsigned;
#define KSWZ(row, colB) ((row) * 256 + ((colB) ^ (((row) & 7) << 4)))
#define SBAR() __builtin_amdgcn_sched_barrier(0)
__device__ __forceinline__ int crow(int r, int hi) { return (r & 3) + 8 * (r >> 2) + 4 * hi; }
__device__ __forceinline__ unsigned cvtpk(float lo, float hi) {
  unsigned r; asm volatile("v_cvt_pk_bf16_f32 %0, %1, %2" : "=v"(r) : "v"(lo), "v"(hi)); return r;
}
template <typename TIn> struct Stage;
template <> struct Stage<bf16>  { using T = bf16x8;
  __device__ static __forceinline__ T ld8(const bf16* p) { return *reinterpret_cast<const bf16x8*>(p); }
  __device__ static __forceinline__ bf16x8 tobf(T x) { return x; } };
template <> struct Stage<float> { using T = f32x8;
  __device__ static __forceinline__ T ld8(const float* p) { return *reinterpret_cast<const f32x8*>(p); }
  __device__ static __forceinline__ bf16x8 tobf(T x) {
    u32x4 w = {cvtpk(x[0], x[1]), cvtpk(x[2], x[3]), cvtpk(x[4], x[5]), cvtpk(x[6], x[7])}; return *reinterpret_cast<bf16x8*>(&w); } };

__device__ __forceinline__ void partialSM(f32x16& p0, f32x16& p1, float& m_reg, float& mn, float& alpha) {
  constexpr float C = SCALE * 1.4426950408889634f;
  float pmax = p0[0]; for (int r = 1; r < 16; ++r) pmax = fmaxf(pmax, p0[r]); for (int r = 0; r < 16; ++r) pmax = fmaxf(pmax, p1[r]);
  { auto rr = __builtin_amdgcn_permlane32_swap(__float_as_uint(pmax), __float_as_uint(pmax), false, false);
    pmax = fmaxf(__uint_as_float(rr[0]), __uint_as_float(rr[1])); }
  if (__builtin_expect(__all(pmax - m_reg <= THR / SCALE), 1)) { mn = m_reg; alpha = 1.f; }
  else { mn = fmaxf(m_reg, pmax); alpha = __builtin_amdgcn_exp2f((m_reg - mn) * C); m_reg = mn; }
  float mnC = -mn * C;
  for (int r = 0; r < 16; ++r) p0[r] = fmaf(p0[r], C, mnC); for (int r = 0; r < 16; ++r) p1[r] = fmaf(p1[r], C, mnC);
  for (int r = 0; r < 16; ++r) p0[r] = __builtin_amdgcn_exp2f(p0[r]);
}
__device__ __forceinline__ void finishSM(f32x16& p0, f32x16& p1, float alpha, float& l_reg, bf16x8& pa0, bf16x8& pa1, bf16x8& pa2, bf16x8& pa3) {
  for (int r = 0; r < 16; ++r) p1[r] = __builtin_amdgcn_exp2f(p1[r]);
  float ps = 0; for (int r = 0; r < 16; ++r) ps += p0[r]; for (int r = 0; r < 16; ++r) ps += p1[r];
  { auto rr = __builtin_amdgcn_permlane32_swap(__float_as_uint(ps), __float_as_uint(ps), false, false);
    ps = __uint_as_float(rr[0]) + __uint_as_float(rr[1]); }
  l_reg = l_reg * alpha + ps;
#define PK4(P, BASE, OUT) do { unsigned a0 = cvtpk(P[BASE + 0], P[BASE + 1]), a1 = cvtpk(P[BASE + 2], P[BASE + 3]);   \
    unsigned b0 = cvtpk(P[BASE + 4], P[BASE + 5]), b1 = cvtpk(P[BASE + 6], P[BASE + 7]);                              \
    auto r0 = __builtin_amdgcn_permlane32_swap(a0, b0, false, false); auto r1 = __builtin_amdgcn_permlane32_swap(a1, b1, false, false); \
    u32x4 w = {r0[0], r1[0], r0[1], r1[1]}; OUT = *reinterpret_cast<bf16x8*>(&w); } while (0)
  PK4(p0, 0, pa0); PK4(p0, 8, pa1); PK4(p1, 0, pa2); PK4(p1, 8, pa3);
#undef PK4
}
__device__ __forceinline__ void qkt(f32x16& p0, f32x16& p1, const bf16* Ks, const bf16x8* qr, int r32, int hi) {
  p0 = f32x16{}; p1 = f32x16{};
  for (int d0 = 0; d0 < 8; ++d0) { int cb = (d0 * 16 + hi * 8) * 2;
    bf16x8 b0 = *reinterpret_cast<const bf16x8*>((const char*)Ks + KSWZ(r32, cb));
    bf16x8 b1 = *reinterpret_cast<const bf16x8*>((const char*)Ks + KSWZ(32 + r32, cb));
    p0 = __builtin_amdgcn_mfma_f32_32x32x16_bf16(b0, qr[d0], p0, 0, 0, 0);
    p1 = __builtin_amdgcn_mfma_f32_32x32x16_bf16(b1, qr[d0], p1, 0, 0, 0); }
}
__device__ __forceinline__ int v_st(int k, int c) { const int kk = (k & ~0xC) | ((k & 4) << 1) | ((k & 8) >> 1); return ((kk >> 3) * 4 + (c >> 5)) * 512 + ((kk & 7) * 32 + (c & 31)) * 2; }
__device__ __forceinline__ int v_rd_base(int lane) { return ((lane & 3) << 3) | (((lane >> 2) & 3) << 6) | (((lane >> 4) & 1) << 5) | (((lane >> 5) & 1) << 8); }
constexpr int v_rd_off(int d0, int ks, int half) { return d0 * 512 + ks * 4096 + half * 2048; }
template <int OFF> __device__ __forceinline__ s16x4 tr_read(int vb) {
  s16x4 r; asm volatile("ds_read_b64_tr_b16 %0, %1 offset:%2" : "=&v"(r) : "v"(vb), "i"(OFF) : "memory"); return r;
}
template <int D0> __device__ __forceinline__ void pv_one(f32x16& od, int vb, bf16x8 pa0, bf16x8 pa1, bf16x8 pa2, bf16x8 pa3) {
  const s16x4 l0 = tr_read<v_rd_off(D0, 0, 0)>(vb), h0 = tr_read<v_rd_off(D0, 0, 1)>(vb), l1 = tr_read<v_rd_off(D0, 1, 0)>(vb), h1 = tr_read<v_rd_off(D0, 1, 1)>(vb);
  const s16x4 l2 = tr_read<v_rd_off(D0, 2, 0)>(vb), h2 = tr_read<v_rd_off(D0, 2, 1)>(vb), l3 = tr_read<v_rd_off(D0, 3, 0)>(vb), h3 = tr_read<v_rd_off(D0, 3, 1)>(vb);
  asm volatile("s_waitcnt lgkmcnt(0)" ::: "memory"); SBAR();
#define PK(L, H) (bf16x8){L[0], L[1], L[2], L[3], H[0], H[1], H[2], H[3]}
  od = __builtin_amdgcn_mfma_f32_32x32x16_bf16(pa0, PK(l0, h0), od, 0, 0, 0);
  od = __builtin_amdgcn_mfma_f32_32x32x16_bf16(pa1, PK(l1, h1), od, 0, 0, 0);
  od = __builtin_amdgcn_mfma_f32_32x32x16_bf16(pa2, PK(l2, h2), od, 0, 0, 0);
  od = __builtin_amdgcn_mfma_f32_32x32x16_bf16(pa3, PK(l3, h3), od, 0, 0, 0);
#undef PK
}
__device__ __forceinline__ void pv_d0(f32x16* o, int vb, bf16x8 pa0, bf16x8 pa1, bf16x8 pa2, bf16x8 pa3) {
  pv_one<0>(o[0], vb, pa0, pa1, pa2, pa3); pv_one<1>(o[1], vb, pa0, pa1, pa2, pa3); pv_one<2>(o[2], vb, pa0, pa1, pa2, pa3); pv_one<3>(o[3], vb, pa0, pa1, pa2, pa3);
}

template <typename TQ>
__device__ __forceinline__ void attn_dense_body(const TQ* Qb, const bf16* __restrict__ Kh, const bf16* __restrict__ Vh,
                                                unsigned short* Ob, int seq, char* lds) {
  using St = Stage<bf16>; using SQ = Stage<TQ>;
  const int tid = threadIdx.x, wid = tid >> 6, lane = tid & 63, r32 = lane & 31, hi = lane >> 5;
  bf16* V_lds = (bf16*)lds; bf16* K_lds = (bf16*)(lds + 2 * SHM_V);
  float* ws = (float*)(lds + 2 * SHM_V + 2 * SHM_K) + wid * 64; float* li_l = ws; float* al_l = ws + 32;
  float m_reg = -1e30f, l_reg = 0; f32x16 o[4] = {}; bf16x8 qr[8];
  const TQ* Qw = Qb + (long)(wid * QBLK + r32) * LDQ + hi * 8;
#pragma unroll
  for (int d0 = 0; d0 < 8; ++d0) qr[d0] = SQ::tobf(SQ::ld8(Qw + d0 * 16));
  const int sr = tid >> 4, sc = (tid & 15) * 8, vst0 = v_st(sr, sc), vst1 = v_st(32 + sr, sc);
  const int vb0 = (int)(uintptr_t)V_lds + v_rd_base(lane);
  struct { typename St::T vs0, vs1, ks0, ks1; } sr_[SDEPTH];
#define SLOAD(i, k0) do { sr_[i].vs0 = St::ld8(&Vh[(long)((k0) + sr) * LDK + sc]); sr_[i].vs1 = St::ld8(&Vh[(long)((k0) + 32 + sr) * LDK + sc]); \
    sr_[i].ks0 = St::ld8(&Kh[(long)((k0) + sr) * LDK + sc]); sr_[i].ks1 = St::ld8(&Kh[(long)((k0) + 32 + sr) * LDK + sc]); } while (0)
#define SWRITE(b, i) do { *(bf16x8*)((char*)V_lds + (b) * SHM_V + vst0) = St::tobf(sr_[i].vs0);          \
    *(bf16x8*)((char*)V_lds + (b) * SHM_V + vst1) = St::tobf(sr_[i].vs1); int kc = sc * 2;               \
    *(bf16x8*)((char*)K_lds + (b) * SHM_K + KSWZ(sr, kc)) = St::tobf(sr_[i].ks0);                       \
    *(bf16x8*)((char*)K_lds + (b) * SHM_K + KSWZ(32 + sr, kc)) = St::tobf(sr_[i].ks1); } while (0)
#define SWAIT() do { if constexpr (SDEPTH == 2) asm volatile("s_waitcnt vmcnt(4)" ::: "memory"); else asm volatile("s_waitcnt vmcnt(0)" ::: "memory"); } while (0)
#define RESC(a) do { if (__any((a) < 1.f)) { if (hi == 0) al_l[r32] = (a); asm volatile("s_waitcnt lgkmcnt(0)" ::: "memory"); \
    for (int d = 0; d < 4; ++d) for (int r = 0; r < 16; ++r) o[d][r] *= al_l[crow(r, hi)]; } } while (0)
  f32x16 pA0, pA1, pB0, pB1; float mnA, mnB, alA, alB; bf16x8 pa0, pa1, pa2, pa3; const int NT = seq / KVBLK;
  constexpr int SE = 0, SO = SDEPTH - 1;
  SLOAD(SE, 0); asm volatile("s_waitcnt vmcnt(0)" ::: "memory"); SWRITE(0, SE); __syncthreads();
  qkt(pA0, pA1, K_lds, qr, r32, hi); partialSM(pA0, pA1, m_reg, mnA, alA);
  SLOAD(SO, KVBLK); if constexpr (SDEPTH == 2) { if (2 < NT) SLOAD(SE, 2 * KVBLK); }
  SWAIT(); SWRITE(1, SO); __syncthreads();
  for (int j = 1; j + 1 < NT; j += 2) {
    SBAR(); qkt(pB0, pB1, (bf16*)((char*)K_lds + SHM_K), qr, r32, hi);
    finishSM(pA0, pA1, alA, l_reg, pa0, pa1, pa2, pa3); SBAR();
    SLOAD(SO, (j + SDEPTH) * KVBLK); SBAR();
    pv_d0(o, vb0, pa0, pa1, pa2, pa3); partialSM(pB0, pB1, m_reg, mnB, alB);
    __syncthreads(); SWAIT(); SWRITE(0, SE);
    RESC(alB); __syncthreads();
    SBAR(); qkt(pA0, pA1, K_lds, qr, r32, hi);
    finishSM(pB0, pB1, alB, l_reg, pa0, pa1, pa2, pa3); SBAR();
    if (SDEPTH == 1 || j + 3 < NT) SLOAD(SE, (j + 1 + SDEPTH) * KVBLK); SBAR();
    pv_d0(o, vb0 + (int)SHM_V, pa0, pa1, pa2, pa3); partialSM(pA0, pA1, m_reg, mnA, alA);
    __syncthreads(); SWAIT(); SWRITE(1, SO);
    RESC(alA); __syncthreads();
  }
  SBAR(); qkt(pB0, pB1, (bf16*)((char*)K_lds + SHM_K), qr, r32, hi);
  finishSM(pA0, pA1, alA, l_reg, pa0, pa1, pa2, pa3); SBAR();
  pv_d0(o, vb0, pa0, pa1, pa2, pa3); partialSM(pB0, pB1, m_reg, mnB, alB);
  __syncthreads(); RESC(alB);
  finishSM(pB0, pB1, alB, l_reg, pa0, pa1, pa2, pa3); SBAR();
  pv_d0(o, vb0 + (int)SHM_V, pa0, pa1, pa2, pa3);
  if (hi == 0) li_l[r32] = l_reg; asm volatile("s_waitcnt lgkmcnt(0)" ::: "memory");
  float rli[16];
#pragma unroll
  for (int r = 0; r < 16; ++r) rli[r] = __builtin_amdgcn_rcpf(li_l[crow(r, hi)]);
  unsigned short* Ow = Ob + (long)(wid * QBLK) * LDO;
#pragma unroll
  for (int r = 0; r < 16; ++r) { int orow = crow(r, hi);
    for (int d0 = 0; d0 < 4; ++d0) Ow[(long)orow * LDO + d0 * 32 + r32] = (unsigned short)(cvtpk(o[d0][r] * rli[r], 0.f) & 0xffffu); }
#undef SLOAD
#undef SWRITE
#undef SWAIT
#undef RESC
}
}
constexpr int DM = 1024, NPROW = 8192, M = 16384;
constexpr int PT = 256, ST = 2048, PAST = 512;
constexpr int PJ = 3584, MIXW = 1536, DFF = 2816, QKVN = 1536;
constexpr int KVSEQ_S = PAST + ST;
constexpr float EPS = 1e-6f;
constexpr size_t OUT_Y = 0, OUT_STATE = 16777216, OUT_CK = 25165824, OUT_CV = 27262976;

constexpr size_t MiB = 1u << 20;
constexpr size_t WS_CTL = 0, CTL_ZERO_BYTES = 1 * MiB;
constexpr size_t WS_MOD = 1 * MiB;
constexpr size_t WS_WIN = 2 * MiB, WS_WOUT = 9 * MiB, WS_WF1_0 = 12 * MiB, WS_WF2_0 = 23 * MiB, WS_POOLW = 28 * MiB + 512 * 1024;
constexpr size_t WS_HM = 30 * MiB;
constexpr size_t WS_PROJ = 78 * MiB;
constexpr size_t WS_S = 190 * MiB;
constexpr size_t WS_OF32 = 78 * MiB;
constexpr size_t WS_WQKV = 142 * MiB, WS_WO = 145 * MiB, WS_WF1_1 = 147 * MiB, WS_WF2_1 = 158 * MiB;
constexpr size_t WS_HID = 164 * MiB;
constexpr size_t WS_QKVRAW = 78 * MiB;
constexpr size_t WS_Q = 164 * MiB;
constexpr size_t WS_K = 238 * MiB, WS_V = 247 * MiB;
constexpr size_t WS_END = 256 * MiB;
constexpr int CW_BAR = 4096;

constexpr int NWAVES = 8;
constexpr int RING_BYTES = 131072, LDSCTL_OFF = RING_BYTES, MISC_OFF = LDSCTL_OFF + 320, LDS_BYTES = 147456;

#ifndef MK_N_LAUNCHES
#define MK_N_LAUNCHES 1
#endif
constexpr int NPHASES = 18;

#define GAS __attribute__((address_space(1)))
#define LAS __attribute__((address_space(3)))
typedef unsigned short bf16;
typedef unsigned v4u __attribute__((ext_vector_type(4)));
typedef unsigned v2u __attribute__((ext_vector_type(2)));
typedef float f32x4 __attribute__((ext_vector_type(4)));
#define LDS_WAIT() asm volatile("s_waitcnt lgkmcnt(0)" ::: "memory")
#define VM_WAIT() asm volatile("s_waitcnt vmcnt(0)" ::: "memory")
__device__ __forceinline__ unsigned f2bf(float f) { unsigned u = __builtin_bit_cast(unsigned, f); return (u + 0x7fffu + ((u >> 16) & 1u)) >> 16; }
__device__ __forceinline__ unsigned pk2(float lo, float hi) { return f2bf(lo) | (f2bf(hi) << 16); }
__device__ __forceinline__ float bf2f(unsigned h) { return __builtin_bit_cast(float, h << 16); }
__device__ __forceinline__ float bflo(unsigned w) { return __builtin_bit_cast(float, w << 16); }
__device__ __forceinline__ float bfhi(unsigned w) { return __builtin_bit_cast(float, w & 0xffff0000u); }
__device__ __forceinline__ float wave_sum(float v) {
#pragma unroll
    for (int o = 1; o < 64; o <<= 1) v += __shfl_xor(v, o);
    return v;
}
__device__ __forceinline__ float log_sigmoid(float x) { return x >= 0.f ? -log1pf(expf(-x)) : x - log1pf(expf(x)); }

typedef GAS unsigned gu32;
typedef GAS unsigned long long gu64;
#define RLX_AGENT __ATOMIC_RELAXED, __HIP_MEMORY_SCOPE_AGENT
#define XB_TMO      128
#define XB_XCNT(j)  (256  + 64 * (j))
#define XB_XSUB(j)  (1280 + 64 * (j))
#define XB_XGEN(j)  (2304 + 64 * (j))
#define XB_TOP      3328
#define XB_TOPGEN   3392
#define XCD_BAR_WORDS 3456
#define XB_SPIN_CAP (1u << 18)

__device__ __forceinline__ unsigned xb_ld(unsigned* p)              { return __hip_atomic_load(p, __ATOMIC_RELAXED, __HIP_MEMORY_SCOPE_AGENT); }
__device__ __forceinline__ unsigned xb_add(unsigned* p, unsigned v) { return __hip_atomic_fetch_add(p, v, __ATOMIC_RELAXED, __HIP_MEMORY_SCOPE_AGENT); }
__device__ __forceinline__ unsigned xb_xcc_id() { return (unsigned)__builtin_amdgcn_s_getreg((3 << 11) | 20) & 0xFu; }
#define XB_SPIN(cond, bar) do { unsigned _sp = 0; while (cond) { __builtin_amdgcn_s_sleep(1); \
    if ((++_sp & 255u) == 0u) { if (xb_ld(&(bar)[XB_TMO])) break; if (_sp > XB_SPIN_CAP) { atomicAdd(&(bar)[XB_TMO], 1u); break; } } } } while (0)

struct XcdBarrier {
    unsigned* bar; unsigned x;
    volatile LAS unsigned* st;
};

__device__ __forceinline__ XcdBarrier xcd_barrier_post(unsigned* bar, volatile LAS unsigned* st) {
    XcdBarrier b; b.bar = bar; b.x = xb_xcc_id(); b.st = st;
    if (threadIdx.x == 0) (void)xb_add(&bar[XB_XCNT(b.x)], 1u);
    return b;
}
__device__ __forceinline__ void xcd_barrier_complete(unsigned* bar, unsigned x, unsigned& nloc, unsigned& nx) {
    const unsigned G = gridDim.x * gridDim.y * gridDim.z;
    unsigned sum, cnt, mine, sp = 0u;
    for (;;) {
        sum = 0u; cnt = 0u; mine = 0u;
#pragma unroll
        for (unsigned j = 0; j < 16; ++j) { const unsigned c = xb_ld(&bar[XB_XCNT(j)]); sum += c; cnt += (c > 0u) ? 1u : 0u; mine = (j == x) ? c : mine; }
        if (sum == G) break;
        __builtin_amdgcn_s_sleep(1);
        if ((++sp & 255u) == 0u) { if (xb_ld(&bar[XB_TMO])) break; if (sp > XB_SPIN_CAP) { atomicAdd(&bar[XB_TMO], 1u); break; } }
    }
    nloc = mine > 0u ? mine : 1u; nx = cnt > 0u ? cnt : 1u;
}

__device__ __forceinline__ void xcd_barrier(const XcdBarrier& b) {
    asm volatile("s_waitcnt vmcnt(0)" ::: "memory");
    __syncthreads();
    if (threadIdx.x == 0) {
        unsigned* bar = b.bar;
        __builtin_amdgcn_s_waitcnt(0);
        unsigned nloc = b.st[0], nx = b.st[1];
        if (nloc == 0u) { xcd_barrier_complete(bar, b.x, nloc, nx); b.st[0] = nloc; b.st[1] = nx; }
        const unsigned old = xb_add(&bar[XB_XSUB(b.x)], 1u);
        const unsigned gen = old / nloc;
        if (old + 1u == (gen + 1u) * nloc) {
            __builtin_amdgcn_fence(__ATOMIC_RELEASE, "agent");
            asm volatile("s_waitcnt vmcnt(0)" ::: "memory");
            const unsigned og = xb_add(&bar[XB_TOP], 1u);
            const unsigned tg = og / nx;
            if (og + 1u == (tg + 1u) * nx) xb_add(&bar[XB_TOPGEN], 1u);
            else XB_SPIN(xb_ld(&bar[XB_TOPGEN]) == tg, bar);
            __builtin_amdgcn_fence(__ATOMIC_ACQUIRE, "agent");
            xb_add(&bar[XB_XGEN(b.x)], 1u);
            asm volatile("s_waitcnt vmcnt(0)" ::: "memory");
        } else {
            XB_SPIN(xb_ld(&bar[XB_XGEN(b.x)]) == gen, bar);
            __builtin_amdgcn_fence(__ATOMIC_ACQUIRE, "agent");
            asm volatile("s_waitcnt vmcnt(0)" ::: "memory");
        }
    }
    __syncthreads();
}


struct Args { const float* in[22]; float* out; unsigned char* ws; int ph_lo, ph_hi; };

__device__ __forceinline__ int row_type(int row) { return row < NPROW ? 0 : 1 + ((row - NPROW) >> 11); }
__device__ __forceinline__ const float* mod_ptr(const Args& a, int layer, int row, int chunk) { return (const float*)(a.ws + WS_MOD) + (size_t)(layer * 5 + row_type(row)) * 6144 + chunk * 1024; }
__device__ __forceinline__ const float* x_in_row(const Args& a, int row) { return row < NPROW ? a.in[0] + (size_t)row * DM : a.in[1] + (size_t)(row - NPROW) * DM; }

template <int MAP> __device__ __forceinline__ int wmap(int n) { if (MAP == 2) { const int j = n < DFF ? n : n - DFF; return (j >> 7) * 256 + (j & 127) + (n < DFF ? 0 : 128); } return n; }
template <int MAP> __device__ __forceinline__ float wscale(int n) { if (MAP == 1) return n < 512 ? 0.08838834764831845f : 1.f; return 1.f; }
template <int MAP> __device__ __forceinline__ void wconv_item(const float* W, int K, int N, bf16* WT, LAS float* scr, int item, int lane) {
    const int nblk = N / 32, kb = item / nblk, nb = item % nblk, k0 = 64 * kb, n0 = 32 * nb;
#pragma unroll 8
    for (int i = 0; i < 32; ++i) { const int kk = 2 * i + (lane >> 5); scr[kk * 33 + (lane & 31)] = W[(size_t)(k0 + kk) * N + n0 + (lane & 31)]; }
    LDS_WAIT(); asm volatile("" ::: "memory");
    const int c = lane & 7;
#pragma unroll
    for (int j = 0; j < 4; ++j) { const int n = (lane >> 3) + 8 * j; const LAS float* s = scr + (8 * c) * 33 + n; const float sc = wscale<MAP>(n0 + n);
        v4u o; o.x = pk2(s[0 * 33] * sc, s[1 * 33] * sc); o.y = pk2(s[2 * 33] * sc, s[3 * 33] * sc); o.z = pk2(s[4 * 33] * sc, s[5 * 33] * sc); o.w = pk2(s[6 * 33] * sc, s[7 * 33] * sc);
        *(v4u*)(WT + (size_t)wmap<MAP>(n0 + n) * K + k0 + 8 * c) = o; }
    LDS_WAIT(); asm volatile("" ::: "memory");
}

__device__ __forceinline__ void ph_prologue(const Args& a, LAS unsigned char* lds, int tid, int lane, int wave, int gw, int NGW) {
    if (blockIdx.x < 192) {
        const int item = blockIdx.x, l = item / 96, n0 = (item % 96) * 64;
        LAS float* sv = (LAS float*)lds;
        LAS float* part = (LAS float*)(lds + 32768);
        for (int i = tid; i < 5 * 1024; i += 512) { const int r = i >> 10, k = i & 1023; const float c = r == 0 ? a.in[6][k] : a.in[5][(r - 1) * 1024 + k]; sv[i] = c / (1.f + expf(-c)); }
        __syncthreads();
        float acc[5] = {0.f, 0.f, 0.f, 0.f, 0.f};
        const float* wp = a.in[7] + ((size_t)l * 1024 + wave * 128) * 6144 + n0 + lane;
#pragma unroll 8
        for (int k = 0; k < 128; ++k) { const float wv = wp[(size_t)k * 6144];
#pragma unroll
            for (int r = 0; r < 5; ++r) acc[r] += sv[r * 1024 + wave * 128 + k] * wv; }
#pragma unroll
        for (int r = 0; r < 5; ++r) part[(wave * 5 + r) * 64 + lane] = acc[r];
        __syncthreads();
        if (tid < 320) { const int r = tid >> 6, ln = tid & 63; float s = a.in[8][l * 6144 + n0 + ln];
#pragma unroll
            for (int w = 0; w < 8; ++w) s += part[(w * 5 + r) * 64 + ln];
            ((float*)(a.ws + WS_MOD))[(size_t)(l * 5 + r) * 6144 + n0 + ln] = s; }
        __syncthreads();
    }
    LAS float* scr = (LAS float*)(lds + wave * 16384);
    constexpr int I_IN = 16 * (PJ / 32), I_OUT = 24 * 32, I_F1 = 16 * (2 * DFF / 32), I_F2 = 44 * 32;
    for (int it = gw; it < I_IN + I_OUT + I_F1 + I_F2; it += NGW) {
        int r = it;
        if (r < I_IN) { wconv_item<1>(a.in[12], 1024, PJ, (bf16*)(a.ws + WS_WIN), scr, r, lane); continue; } r -= I_IN;
        if (r < I_OUT) { wconv_item<0>(a.in[17], MIXW, 1024, (bf16*)(a.ws + WS_WOUT), scr, r, lane); continue; } r -= I_OUT;
        if (r < I_F1) { wconv_item<2>(a.in[10], 1024, 2 * DFF, (bf16*)(a.ws + WS_WF1_0), scr, r, lane); continue; } r -= I_F1;
        wconv_item<0>(a.in[11], DFF, 1024, (bf16*)(a.ws + WS_WF2_0), scr, r, lane);
    }
}
__device__ __forceinline__ void job_wconv_l1(const Args& a, LAS unsigned char* lds, int lane, int wave, int gw, int NGW) {
    LAS float* scr = (LAS float*)(lds + wave * 16384);
    constexpr int I_QKV = 16 * (QKVN / 32), I_O = 16 * 32, I_F1 = 16 * (2 * DFF / 32), I_F2 = 44 * 32;
    for (int it = gw; it < I_QKV + I_O + I_F1 + I_F2; it += NGW) {
        int r = it;
        if (r < I_QKV) { wconv_item<0>(a.in[18], 1024, QKVN, (bf16*)(a.ws + WS_WQKV), scr, r, lane); continue; } r -= I_QKV;
        if (r < I_O) { wconv_item<0>(a.in[21], 1024, 1024, (bf16*)(a.ws + WS_WO), scr, r, lane); continue; } r -= I_O;
        if (r < I_F1) { wconv_item<2>(a.in[10] + (size_t)1024 * 2 * DFF, 1024, 2 * DFF, (bf16*)(a.ws + WS_WF1_1), scr, r, lane); continue; } r -= I_F1;
        wconv_item<0>(a.in[11] + (size_t)DFF * 1024, DFF, 1024, (bf16*)(a.ws + WS_WF2_1), scr, r, lane);
    }
}
__device__ __forceinline__ void job_cache_conv(const Args& a, int gtid, int NT) {
    bf16* Kb = (bf16*)(a.ws + WS_K); bf16* Vb = (bf16*)(a.ws + WS_V);
    for (int i = gtid; i < 4 * PAST * 256 / 4; i += NT) {
        const int e = i * 4, bs = e / (PAST * 256), rem = e % (PAST * 256);
        const f32x4 k = *(const f32x4*)(a.in[3] + e), v = *(const f32x4*)(a.in[4] + e);
        const size_t d = (size_t)(NPROW + bs * KVSEQ_S) * 256 + rem;
        v2u ko, vo; ko.x = pk2(k.x, k.y); ko.y = pk2(k.z, k.w); vo.x = pk2(v.x, v.y); vo.y = pk2(v.z, v.w);
        *(v2u*)(Kb + d) = ko; *(v2u*)(Vb + d) = vo;
    }
}

__device__ __forceinline__ void normmod_row(const float* xrow, const float* gain, const float* sc, const float* sh, bf16* orow, int lane) {
    f32x4 v[4]; float s = 0.f;
#pragma unroll
    for (int j = 0; j < 4; ++j) { v[j] = ((const f32x4*)xrow)[lane + 64 * j]; s += (v[j].x * v[j].x + v[j].y * v[j].y) + (v[j].z * v[j].z + v[j].w * v[j].w); }
    const float rstd = 1.f / sqrtf(wave_sum(s) * (1.f / DM) + EPS);
#pragma unroll
    for (int j = 0; j < 4; ++j) { const f32x4 g = ((const f32x4*)gain)[lane + 64 * j], c = ((const f32x4*)sc)[lane + 64 * j], h = ((const f32x4*)sh)[lane + 64 * j];
        const f32x4 y = (v[j] * rstd * g) * (c + 1.f) + h; v2u o; o.x = pk2(y.x, y.y); o.y = pk2(y.z, y.w); ((v2u*)orow)[lane + 64 * j] = o; }
}
__device__ __forceinline__ void resid_row(const float* xrow, const float* orow, const float* gA, const float* gate, float* xo, const float* gB, const float* sc, const float* sh, bf16* hrow, int lane) {
    f32x4 x[4], o[4]; float s = 0.f;
#pragma unroll
    for (int j = 0; j < 4; ++j) { x[j] = ((const f32x4*)xrow)[lane + 64 * j]; o[j] = ((const f32x4*)orow)[lane + 64 * j]; s += (o[j].x * o[j].x + o[j].y * o[j].y) + (o[j].z * o[j].z + o[j].w * o[j].w); }
    const float rstd = 1.f / sqrtf(wave_sum(s) * (1.f / DM) + EPS);
    float s1 = 0.f;
#pragma unroll
    for (int j = 0; j < 4; ++j) { const f32x4 g = ((const f32x4*)gA)[lane + 64 * j], gt = ((const f32x4*)gate)[lane + 64 * j];
        x[j] = x[j] + gt * (o[j] * rstd * g); ((f32x4*)xo)[lane + 64 * j] = x[j]; s1 += (x[j].x * x[j].x + x[j].y * x[j].y) + (x[j].z * x[j].z + x[j].w * x[j].w); }
    if (hrow) {
        const float rstd1 = 1.f / sqrtf(wave_sum(s1) * (1.f / DM) + EPS);
#pragma unroll
        for (int j = 0; j < 4; ++j) { const f32x4 g = ((const f32x4*)gB)[lane + 64 * j], c = ((const f32x4*)sc)[lane + 64 * j], h = ((const f32x4*)sh)[lane + 64 * j];
            const f32x4 y = (x[j] * rstd1 * g) * (c + 1.f) + h; v2u w; w.x = pk2(y.x, y.y); w.y = pk2(y.z, y.w); ((v2u*)hrow)[lane + 64 * j] = w; }
    }
}

__device__ __forceinline__ void naive_ret_state(const Args& a, int item, int tid) {
    const int b = item >> 3, h = (item >> 1) & 3, dir = item & 1;
    const float lg = log_sigmoid(a.in[13][dir * 4 + h]);
    const int dv = tid & 255, dkh = tid >> 8;
    const bf16* P = (const bf16*)(a.ws + WS_PROJ);
    float acc[64];
#pragma unroll
    for (int i = 0; i < 64; ++i) acc[i] = 0.f;
    for (int t = 0; t < PT; ++t) {
        const bf16* pr = P + (size_t)(b * PT + t) * PJ;
        const float vv = bf2f(pr[1024 + h * 256 + dv]) * expf(lg * (float)(dir == 0 ? (PT - 1 - t) : t));
        const v4u* kp = (const v4u*)(pr + 512 + h * 128 + dkh * 64);
#pragma unroll
        for (int i8 = 0; i8 < 8; ++i8) { const v4u kk = kp[i8];
            acc[i8 * 8 + 0] += bflo(kk.x) * vv; acc[i8 * 8 + 1] += bfhi(kk.x) * vv; acc[i8 * 8 + 2] += bflo(kk.y) * vv; acc[i8 * 8 + 3] += bfhi(kk.y) * vv;
            acc[i8 * 8 + 4] += bflo(kk.z) * vv; acc[i8 * 8 + 5] += bfhi(kk.z) * vv; acc[i8 * 8 + 6] += bflo(kk.w) * vv; acc[i8 * 8 + 7] += bfhi(kk.w) * vv; }
    }
    float* o = a.out + OUT_STATE + ((size_t)((b * 2 + dir) * 4 + h) * 128 + dkh * 64) * 256 + dv;
#pragma unroll
    for (int i = 0; i < 64; ++i) o[(size_t)i * 256] = acc[i];
}
__device__ __forceinline__ void seq_of_row(int R, int& s0, int& T) { if (R < NPROW) { s0 = R & ~(PT - 1); T = PT; } else { s0 = NPROW + ((R - NPROW) & ~(ST - 1)); T = ST; } }
__device__ __forceinline__ void naive_pool(const Args& a, LAS unsigned char* lds, int item, int tid) {
    const int tile = item >> 2, g = item & 3, R0 = tile * 64, half = 1 << g;
    const bf16* P = (const bf16*)(a.ws + WS_PROJ); bf16* mix = (bf16*)(a.ws + WS_HM);
    LAS float* d = (LAS float*)lds;
    for (int e = tid; e < 64 * 128; e += 512) { const int r = e >> 7, c = e & 127, R = R0 + r; int s0, T; seq_of_row(R, s0, T); const int t = R - s0;
        const int lo = t - half < 0 ? 0 : t - half, hi = t + half > T ? T : t + half; float s = 0.f;
        for (int tt = lo; tt < hi; ++tt) s += bf2f(P[(size_t)(s0 + tt) * PJ + 3072 + g * 128 + c]);
        d[e] = s / (float)(hi - lo) - bf2f(P[(size_t)R * PJ + 3072 + g * 128 + c]); }
    __syncthreads();
    const int e = tid & 127, rg = tid >> 7; float acc[16];
#pragma unroll
    for (int i = 0; i < 16; ++i) acc[i] = 0.f;
    const float* pw = a.in[15] + (size_t)g * 128 * 128 + e;
    for (int c = 0; c < 128; ++c) { const float w = pw[c * 128];
#pragma unroll
        for (int i = 0; i < 16; ++i) acc[i] += d[(rg + 4 * i) * 128 + c] * w; }
    const float ps = a.in[16][g * 128 + e];
#pragma unroll
    for (int i = 0; i < 16; ++i) mix[(size_t)(R0 + rg + 4 * i) * MIXW + 1024 + g * 128 + e] = (bf16)f2bf(acc[i] * ps);
    __syncthreads();
}
__device__ __forceinline__ void naive_ret_out(const Args& a, LAS unsigned char* lds, int item, int lane, int wave) {
    const int R = item >> 2, h = item & 3; int s0, T; seq_of_row(R, s0, T); const int t = R - s0;
    const float lgf = log_sigmoid(a.in[13][h]), lgb = log_sigmoid(a.in[13][4 + h]);
    const bf16* P = (const bf16*)(a.ws + WS_PROJ); bf16* mix = (bf16*)(a.ws + WS_HM);
    LAS float* wsm = (LAS float*)(lds + wave * 8704); LAS float* qs = wsm + 2048;
    LDS_WAIT();
    qs[lane] = bf2f(P[(size_t)R * PJ + h * 128 + lane]); qs[lane + 64] = bf2f(P[(size_t)R * PJ + h * 128 + 64 + lane]);
    LDS_WAIT(); asm volatile("" ::: "memory");
    for (int tp = lane; tp < T; tp += 64) {
        const v4u* kp = (const v4u*)(P + (size_t)(s0 + tp) * PJ + 512 + h * 128); float dot = 0.f;
#pragma unroll
        for (int i8 = 0; i8 < 16; ++i8) { const v4u kk = kp[i8]; const LAS float* q = qs + i8 * 8;
            dot += bflo(kk.x) * q[0] + bfhi(kk.x) * q[1] + bflo(kk.y) * q[2] + bfhi(kk.y) * q[3] + bflo(kk.z) * q[4] + bfhi(kk.z) * q[5] + bflo(kk.w) * q[6] + bfhi(kk.w) * q[7]; }
        const float w = tp < t ? expf(lgf * (float)(t - tp)) : (tp > t ? expf(lgb * (float)(tp - t)) : 2.f);
        wsm[tp] = dot * w;
    }
    LDS_WAIT(); asm volatile("" ::: "memory");
    float y[4] = {0.f, 0.f, 0.f, 0.f};
    const bf16* vp = P + (size_t)s0 * PJ + 1024 + h * 256 + 4 * lane;
#pragma unroll 8
    for (int tp = 0; tp < T; ++tp) { const float s = wsm[tp]; const v2u vv = *(const v2u*)(vp + (size_t)tp * PJ);
        y[0] += s * bflo(vv.x); y[1] += s * bfhi(vv.x); y[2] += s * bflo(vv.y); y[3] += s * bfhi(vv.y); }
    if (R >= NPROW) {
        const int bs = (R - NPROW) >> 11; const float cf = expf(lgf * (float)(t + 1)), cb = expf(lgb * (float)(T - t));
        const float* sf = a.in[2] + ((size_t)((bs * 2 + 0) * 4 + h) * 128) * 256 + 4 * lane; const float* sb = a.in[2] + ((size_t)((bs * 2 + 1) * 4 + h) * 128) * 256 + 4 * lane;
#pragma unroll 4
        for (int dk = 0; dk < 128; ++dk) { const float qf = qs[dk] * cf, qb = qs[dk] * cb; const f32x4 A = *(const f32x4*)(sf + (size_t)dk * 256), B = *(const f32x4*)(sb + (size_t)dk * 256);
            y[0] += qf * A.x + qb * B.x; y[1] += qf * A.y + qb * B.y; y[2] += qf * A.z + qb * B.z; y[3] += qf * A.w + qb * B.w; }
    }
    const float mu = wave_sum((y[0] + y[1]) + (y[2] + y[3])) * (1.f / 256.f);
    const float d0 = y[0] - mu, d1 = y[1] - mu, d2 = y[2] - mu, d3 = y[3] - mu;
    const float var = wave_sum((d0 * d0 + d1 * d1) + (d2 * d2 + d3 * d3)) * (1.f / 256.f);
    const float rs = 1.f / sqrtf(var + EPS);
    const f32x4 gn = *(const f32x4*)(a.in[14] + h * 256 + 4 * lane);
    const v2u gg = *(const v2u*)(P + (size_t)R * PJ + 2048 + h * 256 + 4 * lane);
    const float g0 = bflo(gg.x), g1 = bfhi(gg.x), g2 = bflo(gg.y), g3 = bfhi(gg.y);
    const float o0 = (g0 / (1.f + expf(-g0))) * (d0 * rs * gn.x), o1 = (g1 / (1.f + expf(-g1))) * (d1 * rs * gn.y), o2 = (g2 / (1.f + expf(-g2))) * (d2 * rs * gn.z), o3 = (g3 / (1.f + expf(-g3))) * (d3 * rs * gn.w);
    v2u w; w.x = pk2(o0, o1); w.y = pk2(o2, o3);
    *(v2u*)(mix + (size_t)R * MIXW + h * 256 + 4 * lane) = w;
}
__device__ __forceinline__ int kv_row(int R) { return R < NPROW ? R : NPROW + ((R - NPROW) >> 11) * KVSEQ_S + PAST + ((R - NPROW) & (ST - 1)); }
__device__ __forceinline__ void naive_qkv_post(const Args& a, int item, int lane) {
    const int R = item / 12, slot = item % 12;
    const bf16* raw = (const bf16*)(a.ws + WS_QKVRAW) + (size_t)R * QKVN;
    const int da = (lane >> 5) * 64 + (lane & 31), db = da + 32;
    if (slot >= 10) {
        const int kvh = slot - 10; const float va = bf2f(raw[1280 + kvh * 128 + da]), vb = bf2f(raw[1280 + kvh * 128 + db]);
        bf16* Vb = (bf16*)(a.ws + WS_V) + (size_t)kv_row(R) * 256 + kvh * 128; Vb[da] = raw[1280 + kvh * 128 + da]; Vb[db] = raw[1280 + kvh * 128 + db];
        if (R < NPROW) { float* o = a.out + OUT_CV + (size_t)R * 256 + kvh * 128; o[da] = va; o[db] = vb; }
        return;
    }
    const bool isq = slot < 8; const int src = isq ? slot * 128 : 1024 + (slot - 8) * 128;
    const float xa = bf2f(raw[src + da]), xb = bf2f(raw[src + db]);
    const float rstd = 1.f / sqrtf(wave_sum(xa * xa + xb * xb) * (1.f / 128.f) + EPS);
    const float* gain = isq ? a.in[19] : a.in[20];
    float ya = xa * rstd * gain[da], yb = xb * rstd * gain[db];
    if (!isq && R < NPROW) { float* o = a.out + OUT_CK + (size_t)R * 256 + (slot - 8) * 128; o[da] = ya; o[db] = yb; }
    if (R >= NPROW) {
        const int t = (R - NPROW) & (ST - 1); const float pos = (float)((lane >> 5) ? (t & 63) : (t >> 6));
        const float fr = expf(-(float)(lane & 31) * (9.210340371976184f / 32.f)); const float ang = pos * fr; const float c = cosf(ang), s = sinf(ang);
        const float ra = ya * c - yb * s, rb = yb * c + ya * s; ya = ra; yb = rb;
    }
    if (isq) { bf16* Q = (bf16*)(a.ws + WS_Q) + (size_t)R * 1024 + slot * 128; Q[da] = (bf16)f2bf(ya); Q[db] = (bf16)f2bf(yb); }
    else { bf16* Kb = (bf16*)(a.ws + WS_K) + (size_t)kv_row(R) * 256 + (slot - 8) * 128; Kb[da] = (bf16)f2bf(ya); Kb[db] = (bf16)f2bf(yb); }
}

__global__ void __launch_bounds__(NWAVES * 64, 2) skel_fwd(Args a) {
    extern __shared__ __attribute__((aligned(16))) unsigned char lds_raw[];
    LAS unsigned char* lds = (LAS unsigned char*)lds_raw;
    volatile LAS unsigned* MISC = (volatile LAS unsigned*)(lds + MISC_OFF);
    const int tid = threadIdx.x, lane = tid & 63, wave = __builtin_amdgcn_readfirstlane(tid >> 6);
    const int G = gridDim.x, bx = blockIdx.x;
    const int vcu = (G % 8 == 0) ? (bx % 8) * (G / 8) + bx / 8 : bx;
    const int gw = vcu * NWAVES + wave, NGW = G * NWAVES;
    gu32* ctl = (gu32*)(a.ws + WS_CTL);
    for (int u = tid; u < (LDS_BYTES - LDSCTL_OFF) / 4; u += NWAVES * 64) ((LAS unsigned*)(lds + LDSCTL_OFF))[u] = 0u;
    __syncthreads();
    XcdBarrier bar; bar.bar = (unsigned*)(ctl + CW_BAR); bar.x = 0; bar.st = nullptr;
    if (MK_N_LAUNCHES == 1) bar = xcd_barrier_post((unsigned*)(ctl + CW_BAR), MISC + 8);
    const int lo = a.ph_lo, hi = a.ph_hi;
#define IN(k) (lo <= (k) && (k) < hi)
#define SEAM(k) do { if (IN(k) && IN((k) + 1)) xcd_barrier(bar); } while (0)

    bf16* H = (bf16*)(a.ws + WS_HM); bf16* MIX = (bf16*)(a.ws + WS_HM); bf16* PROJ = (bf16*)(a.ws + WS_PROJ); float* OF32 = (float*)(a.ws + WS_OF32);
    bf16* HID = (bf16*)(a.ws + WS_HID); float* Y = a.out + OUT_Y;
    const float* ng = a.in[9];

    if (IN(0)) { ph_prologue(a, lds, tid, lane, wave, gw, NGW); } SEAM(0);
    if (IN(1)) { for (int m = gw; m < M; m += NGW) normmod_row(x_in_row(a, m), ng + 0 * 1024, mod_ptr(a, 0, m, 1), mod_ptr(a, 0, m, 0), H + (size_t)m * DM, lane); } SEAM(1);
    if (IN(2)) { pg8::Gemm g{H, (const bf16*)(a.ws + WS_WIN), M, PJ, 1024}; pg8::StaticOrder S; S.init(M, PJ, G, bx); pg8::EpiBf16P E{PROJ, PJ};
        pg8::gemm_phase<pg8::EpiBf16P, pg8::StaticOrder, true, true>(lds, g, S, E); } SEAM(2);
    if (IN(3)) { for (int it = bx; it < 256; it += G) naive_ret_state(a, it, tid);
        for (int it = bx; it < 1024; it += G) naive_pool(a, lds, it, tid); } SEAM(3);
    if (IN(4)) { for (int it = gw; it < M * 4; it += NGW) naive_ret_out(a, lds, it, lane, wave); } SEAM(4);
    if (IN(5)) { pg8::Gemm g{MIX, (const bf16*)(a.ws + WS_WOUT), M, 1024, MIXW}; pg8::StaticOrder S; S.init(M, 1024, G, bx); pg8::EpiF32 E{OF32, 1024};
        pg8::gemm_phase<pg8::EpiF32, pg8::StaticOrder, true, true>(lds, g, S, E); } SEAM(5);
    if (IN(6)) { for (int m = gw; m < M; m += NGW) resid_row(x_in_row(a, m), OF32 + (size_t)m * DM, ng + 1 * 1024, mod_ptr(a, 0, m, 2), Y + (size_t)m * DM, ng + 2 * 1024, mod_ptr(a, 0, m, 4), mod_ptr(a, 0, m, 3), H + (size_t)m * DM, lane);
        job_wconv_l1(a, lds, lane, wave, gw, NGW); } SEAM(6);
    if (IN(7)) { pg8::Gemm g{H, (const bf16*)(a.ws + WS_WF1_0), M, 2 * DFF, 1024}; pg8::StaticOrder S; S.init(M, 2 * DFF, G, bx); pg8::EpiSwiGLU E{HID, DFF};
        pg8::gemm_phase<pg8::EpiSwiGLU, pg8::StaticOrder, true, true>(lds, g, S, E); } SEAM(7);
    if (IN(8)) { pg8::Gemm g{HID, (const bf16*)(a.ws + WS_WF2_0), M, 1024, DFF}; pg8::StaticOrder S; S.init(M, 1024, G, bx); pg8::EpiF32 E{OF32, 1024};
        pg8::gemm_phase<pg8::EpiF32, pg8::StaticOrder, true, true>(lds, g, S, E); } SEAM(8);
    if (IN(9)) { for (int m = gw; m < M; m += NGW) resid_row(Y + (size_t)m * DM, OF32 + (size_t)m * DM, ng + 3 * 1024, mod_ptr(a, 0, m, 5), Y + (size_t)m * DM, ng + 4 * 1024, mod_ptr(a, 1, m, 1), mod_ptr(a, 1, m, 0), H + (size_t)m * DM, lane);
        job_cache_conv(a, vcu * 512 + tid, G * 512); } SEAM(9);
    if (IN(10)) { pg8::Gemm g{H, (const bf16*)(a.ws + WS_WQKV), M, QKVN, 1024}; pg8::StaticOrder S; S.init(M, QKVN, G, bx); pg8::EpiBf16P E{(bf16*)(a.ws + WS_QKVRAW), QKVN};
        pg8::gemm_phase<pg8::EpiBf16P, pg8::StaticOrder, true, true>(lds, g, S, E); } SEAM(10);
    if (IN(11)) { for (int it = gw; it < M * 12; it += NGW) naive_qkv_post(a, it, lane); } SEAM(11);
    if (IN(12)) {
        bf16* Q = (bf16*)(a.ws + WS_Q); const bf16* Kb = (const bf16*)(a.ws + WS_K); const bf16* Vb = (const bf16*)(a.ws + WS_V);
        for (int it = bx; it < 512; it += G) {
            int qrow, krow, seq, h;
            if (it < 256) { const int b = it >> 3; h = it & 7; qrow = b * PT; krow = b * PT; seq = PT; }
            else { const int u = it - 256, bs = u >> 6, qb = u & 7; h = (u >> 3) & 7; qrow = NPROW + bs * ST + qb * 256; krow = NPROW + bs * KVSEQ_S; seq = KVSEQ_S; }
            bf16* qp = Q + (size_t)qrow * 1024 + h * 128; const size_t ko = (size_t)krow * 256 + (h >> 2) * 128;
            att::attn_dense_body<att::bf16>((const att::bf16*)qp, (const att::bf16*)(Kb + ko), (const att::bf16*)(Vb + ko), qp, seq, (char*)lds_raw);
            __syncthreads();
        }
    } SEAM(12);
    if (IN(13)) { pg8::Gemm g{(const bf16*)(a.ws + WS_Q), (const bf16*)(a.ws + WS_WO), M, 1024, 1024}; pg8::StaticOrder S; S.init(M, 1024, G, bx); pg8::EpiF32 E{OF32, 1024};
        pg8::gemm_phase<pg8::EpiF32, pg8::StaticOrder, true, true>(lds, g, S, E); } SEAM(13);
    if (IN(14)) { for (int m = gw; m < M; m += NGW) resid_row(Y + (size_t)m * DM, OF32 + (size_t)m * DM, ng + 5 * 1024, mod_ptr(a, 1, m, 2), Y + (size_t)m * DM, ng + 6 * 1024, mod_ptr(a, 1, m, 4), mod_ptr(a, 1, m, 3), H + (size_t)m * DM, lane); } SEAM(14);
    if (IN(15)) { pg8::Gemm g{H, (const bf16*)(a.ws + WS_WF1_1), M, 2 * DFF, 1024}; pg8::StaticOrder S; S.init(M, 2 * DFF, G, bx); pg8::EpiSwiGLU E{HID, DFF};
        pg8::gemm_phase<pg8::EpiSwiGLU, pg8::StaticOrder, true, true>(lds, g, S, E); } SEAM(15);
    if (IN(16)) { pg8::Gemm g{HID, (const bf16*)(a.ws + WS_WF2_1), M, 1024, DFF}; pg8::StaticOrder S; S.init(M, 1024, G, bx); pg8::EpiF32 E{OF32, 1024};
        pg8::gemm_phase<pg8::EpiF32, pg8::StaticOrder, true, true>(lds, g, S, E); } SEAM(16);
    if (IN(17)) { for (int m = gw; m < M; m += NGW) resid_row(Y + (size_t)m * DM, OF32 + (size_t)m * DM, ng + 7 * 1024, mod_ptr(a, 1, m, 5), Y + (size_t)m * DM, nullptr, nullptr, nullptr, nullptr, lane); }
#undef IN
#undef SEAM
}

extern "C" void kernel_launch(void* const* d_in, const int* in_sizes, int n_in, void* d_out, int out_size, void* d_ws, size_t ws_size, hipStream_t stream) {
    static int grid = 0;
    if (grid == 0) {
        if (n_in != 22 || in_sizes[0] != NPROW * DM || out_size != 29360128 || ws_size < WS_END) { fprintf(stderr, "kernel_launch: unexpected shapes (n_in %d, in0 %d, out %d, ws %zu)\n", n_in, n_in > 0 ? in_sizes[0] : -1, out_size, ws_size); grid = -1; return; }
        int dev = 0, cus = 0, per_cu = 0;
        if (hipGetDevice(&dev) != hipSuccess || hipDeviceGetAttribute(&cus, hipDeviceAttributeMultiprocessorCount, dev) != hipSuccess) { grid = -1; return; }
        if (hipFuncSetAttribute((const void*)skel_fwd, hipFuncAttributeMaxDynamicSharedMemorySize, LDS_BYTES) != hipSuccess) { fprintf(stderr, "kernel_launch: hipFuncSetAttribute failed\n"); grid = -1; return; }
        if (hipOccupancyMaxActiveBlocksPerMultiprocessor(&per_cu, (const void*)skel_fwd, NWAVES * 64, LDS_BYTES) != hipSuccess || per_cu < 1) { fprintf(stderr, "kernel_launch: occupancy query reports %d blocks per CU\n", per_cu); }
        (void)hipGetLastError();
        grid = cus;
    }
    if (grid < 0) return;
    (void)hipMemsetAsync((char*)d_ws + WS_CTL, 0, CTL_ZERO_BYTES, stream);
    Args a{};
    for (int i = 0; i < 22; ++i) a.in[i] = (const float*)d_in[i];
    a.out = (float*)d_out; a.ws = (unsigned char*)d_ws;
    if (MK_N_LAUNCHES == 1) { a.ph_lo = 0; a.ph_hi = NPHASES; hipLaunchKernelGGL(skel_fwd, dim3(grid), dim3(NWAVES * 64), LDS_BYTES, stream, a); }
    else { for (int p = 0; p < NPHASES; ++p) { a.ph_lo = p; a.ph_hi = p + 1; hipLaunchKernelGGL(skel_fwd, dim3(grid), dim3(NWAVES * 64), LDS_BYTES, stream, a); } }
    const hipError_t le = hipPeekAtLastError();
    if (le != hipSuccess) fprintf(stderr, "kernel_launch: launch failed: %s\n", hipGetErrorName(le));
}
```

```cpp
#include <hip/hip_runtime.h>
#include <hip/hip_bf16.h>
#include <cstdio>
#include <cstdint>
#include <cmath>
namespace pg8 {
#define PG8_LAS __attribute__((address_space(3)))
typedef unsigned short bf16_t;
typedef short bf16x8 __attribute__((ext_vector_type(8)));
typedef float f32x4 __attribute__((ext_vector_type(4)));
typedef unsigned u32x4 __attribute__((ext_vector_type(4)));
constexpr int BM = 256, BK = 64, HALF = 128, HTB = HALF * BK * 2  , STAGE_BYTES = 8 * HTB, NXCD = 8, WGM = 8;

__host__ __device__ __forceinline__ int lds_byte(int r, int c) { const int st = (r >> 4) * 2 + (c >> 5), rr = r & 15, cc = c & 31, ob = rr * 64 + cc * 2; return st * 1024 + (ob ^ (((ob >> 9) & 1) << 5)); }
__host__ __device__ __forceinline__ void stage_rc(int b, int& R, int& C) { const int st = b / 1024, sb = b % 1024, swz = sb ^ (((sb >> 9) & 1) << 5); R = (st >> 1) * 16 + swz / 64; C = (st & 1) * 32 + (swz % 64) / 2; }
__host__ __device__ __forceinline__ int perm32(int rho) { const int n = rho >> 4, i = rho & 15; return 8 * (i >> 2) + 4 * n + (i & 3); }

struct Unit { int pm, pn; };
struct Gemm { const bf16_t* A; const bf16_t* Bt; int M, N, K; };

struct StaticOrder {
    int nM, nN, nwg, G, c;
    __host__ __device__ void init(int M, int N, int G_, int c_) { nM = M / BM; nN = N / BM; nwg = nM * nN; G = G_; c = c_; }
    __host__ __device__ bool next(int i, Unit& u) const {
        const long L = (long)i * G + c; if (L >= nwg) return false;
        int wgid = (int)L; { const int q = nwg / NXCD, r = nwg % NXCD, xcd = wgid % NXCD, off = wgid / NXCD; wgid = (xcd < r ? xcd * (q + 1) : r * (q + 1) + (xcd - r) * q) + off; }
        const int nig = WGM * nN, gid = wgid / nig, fm = gid * WGM, gsz = (nM - fm) < WGM ? (nM - fm) : WGM;
        u.pm = fm + ((wgid % nig) % gsz); u.pn = (wgid % nig) / gsz; return true;
    }
    __device__ __forceinline__ void a_ready(const Unit&) const {}
    __device__ __forceinline__ void done(const Unit&) const {}
};

__device__ __forceinline__ unsigned cvt_pk_bf16(float lo, float hi) { unsigned r; asm volatile("v_cvt_pk_bf16_f32 %0, %1, %2" : "=v"(r) : "v"(lo), "v"(hi)); return r; }

struct EpiBf16P {
    static constexpr bool PERM = true, AFTER_DRAIN = false;
    bf16_t* O; int ldc;
    __device__ __forceinline__ void operator()(const f32x4 (&acc)[2][2][4][2], const Unit& u, int wr, int wc, int fr, int fq) const {
        const int row0 = u.pm * BM + wr * 64 + fr, col0 = u.pn * BM + wc * 32 + 8 * fq;
#pragma unroll
        for (int ai = 0; ai < 2; ++ai)
#pragma unroll
            for (int m = 0; m < 4; ++m) { bf16_t* rowp = O + (size_t)(row0 + ai * HALF + m * 16) * ldc + col0;
#pragma unroll
                for (int bj = 0; bj < 2; ++bj) { const f32x4 v0 = acc[ai][bj][m][0], v1 = acc[ai][bj][m][1];
                    u32x4 w; w.x = cvt_pk_bf16(v0[0], v0[1]); w.y = cvt_pk_bf16(v0[2], v0[3]); w.z = cvt_pk_bf16(v1[0], v1[1]); w.w = cvt_pk_bf16(v1[2], v1[3]);
                    *(u32x4*)(rowp + bj * HALF) = w; } }
    }
};

struct EpiF32 {
    static constexpr bool PERM = false, AFTER_DRAIN = false;
    float* C; int ldc;
    __device__ __forceinline__ void operator()(const f32x4 (&acc)[2][2][4][2], const Unit& u, int wr, int wc, int fr, int fq) const {
        const int row0 = u.pm * BM + wr * 64 + fr, col0 = u.pn * BM + wc * 32 + 4 * fq;
#pragma unroll
        for (int ai = 0; ai < 2; ++ai)
#pragma unroll
            for (int m = 0; m < 4; ++m) { float* rowp = C + (size_t)(row0 + ai * HALF + m * 16) * ldc + col0;
#pragma unroll
                for (int bj = 0; bj < 2; ++bj)
#pragma unroll
                    for (int n = 0; n < 2; ++n) *(f32x4*)(rowp + bj * HALF + n * 16) = acc[ai][bj][m][n]; }
    }
};

__device__ __forceinline__ float silu_f(float a) { return a * __builtin_amdgcn_rcpf(1.0f + __builtin_amdgcn_exp2f(-1.4426950408889634f * a)); }

struct EpiSwiGLU {
    static constexpr bool PERM = true, AFTER_DRAIN = false;
    bf16_t* O; int ldc;
    __device__ __forceinline__ void operator()(const f32x4 (&acc)[2][2][4][2], const Unit& u, int wr, int wc, int fr, int fq) const {
        const int row0 = u.pm * BM + wr * 64 + fr, col0 = u.pn * HALF + wc * 32 + 8 * fq;
#pragma unroll
        for (int ai = 0; ai < 2; ++ai)
#pragma unroll
            for (int m = 0; m < 4; ++m) { bf16_t* rowp = O + (size_t)(row0 + ai * HALF + m * 16) * ldc + col0;
                const f32x4 a0 = acc[ai][0][m][0], a1 = acc[ai][0][m][1], b0 = acc[ai][1][m][0], b1 = acc[ai][1][m][1];
                u32x4 w; w.x = cvt_pk_bf16(silu_f(a0[0]) * b0[0], silu_f(a0[1]) * b0[1]); w.y = cvt_pk_bf16(silu_f(a0[2]) * b0[2], silu_f(a0[3]) * b0[3]);
                w.z = cvt_pk_bf16(silu_f(a1[0]) * b1[0], silu_f(a1[1]) * b1[1]); w.w = cvt_pk_bf16(silu_f(a1[2]) * b1[2], silu_f(a1[3]) * b1[3]);
                *(u32x4*)rowp = w; }
    }
};
template <class Epi, class Sched, bool ALIGN_EPI = false, bool SP2 = false>
__device__ __forceinline__ void gemm_phase(PG8_LAS unsigned char* lds, const Gemm g, const Sched& S, const Epi& E) {
    const int tid = threadIdx.x, wid = __builtin_amdgcn_readfirstlane(tid >> 6), lane = tid & 63, wr = wid >> 2, wc = wid & 3, fr = lane & 15, fq = lane >> 4;
    const int K = g.K, nt = K / BK;
    unsigned voffA[2], voffB[2];
#pragma unroll
    for (int i = 0; i < 2; ++i) { int R, C; stage_rc(tid * 16 + i * 8192, R, C); const int Rb = Epi::PERM ? ((R & ~31) + perm32(R & 31)) : R;
        voffA[i] = (unsigned)(R * K + C) * 2u; voffB[i] = (unsigned)(Rb * K + C) * 2u; }
    const size_t kstep = (size_t)(BK * 2);
    const size_t hstep = (size_t)HALF * K * 2;
    const size_t tstep = 2 * hstep;
    const unsigned ldsw = (unsigned)wid * 1024u;
    const int aoff = lds_byte(wr * 64 + fr, fq * 8), boff = lds_byte(wc * 32 + fr, fq * 8);
#define PG8_SA(b, h) (((b) * 2 + (h)) * HTB)
#define PG8_SB(b, h) ((4 + (b) * 2 + (h)) * HTB)
#define PG8_STAGE(bufoff, gbase, voff) do { _Pragma("unroll") for (int _i = 0; _i < 2; ++_i) \
        __builtin_amdgcn_global_load_lds((const unsigned*)((const char*)(gbase) + (voff)[_i]), (PG8_LAS unsigned*)(lds + (bufoff) + ldsw + _i * 8192), 16, 0, 0); } while (0)
#define PG8_LDA(dst, b, h) do { _Pragma("unroll") for (int m = 0; m < 4; ++m) _Pragma("unroll") for (int k = 0; k < 2; ++k) dst[m][k] = *(const PG8_LAS bf16x8*)(lds + PG8_SA(b, h) + aoff + m * 2048 + k * 1024); } while (0)
#define PG8_LDB(dst, b, h) do { _Pragma("unroll") for (int n = 0; n < 2; ++n) _Pragma("unroll") for (int k = 0; k < 2; ++k) dst[n][k] = *(const PG8_LAS bf16x8*)(lds + PG8_SB(b, h) + boff + n * 2048 + k * 1024); } while (0)
#define PG8_MMA(ai, bj, At, Bt) do { __builtin_amdgcn_s_setprio(1); _Pragma("unroll") for (int m = 0; m < 4; ++m) _Pragma("unroll") for (int n = 0; n < 2; ++n) _Pragma("unroll") for (int k = 0; k < 2; ++k) \
        acc[ai][bj][m][n] = __builtin_amdgcn_mfma_f32_16x16x32_bf16(Bt[n][k], At[m][k], acc[ai][bj][m][n], 0, 0, 0); __builtin_amdgcn_s_setprio(0); } while (0)
#define PG8_WAIT_V(n) asm volatile("s_waitcnt vmcnt(" #n ")" ::: "memory")
#define PG8_WAIT_L(n) asm volatile("s_waitcnt lgkmcnt(" #n ")" ::: "memory")
#define PG8_BAR __builtin_amdgcn_s_barrier()
#define PG8_SCHED __builtin_amdgcn_sched_barrier(0)
    Unit cur, nxt; int ui = 0;
    if (!S.next(0, cur)) return;
    f32x4 acc[2][2][4][2];
#pragma unroll
    for (int a = 0; a < 2; ++a)
#pragma unroll
        for (int b = 0; b < 2; ++b)
#pragma unroll
            for (int m = 0; m < 4; ++m)
#pragma unroll
                for (int n = 0; n < 2; ++n) acc[a][b][m][n] = (f32x4){0.f, 0.f, 0.f, 0.f};
    bf16x8 At[4][2], B0[2][2], B1[2][2];
    const char* cA = (const char*)g.A + (size_t)cur.pm * tstep; const char* cB = (const char*)g.Bt + (size_t)cur.pn * tstep;
    S.a_ready(cur);
    if constexpr (SP2) {
        PG8_STAGE(PG8_SB(0, 0), cB, voffB); PG8_STAGE(PG8_SB(0, 1), cB + hstep, voffB); PG8_STAGE(PG8_SA(0, 0), cA, voffA); PG8_STAGE(PG8_SA(0, 1), cA + hstep, voffA);
        if (wr == 1) PG8_BAR;
        PG8_WAIT_V(2); PG8_BAR;
        PG8_STAGE(PG8_SB(1, 0), cB + kstep, voffB); PG8_STAGE(PG8_SA(1, 0), cA + kstep, voffA); PG8_STAGE(PG8_SB(1, 1), cB + hstep + kstep, voffB);
        PG8_WAIT_V(6); PG8_BAR;
    } else {
        PG8_STAGE(PG8_SB(0, 0), cB, voffB); PG8_STAGE(PG8_SA(0, 0), cA, voffA); PG8_STAGE(PG8_SB(0, 1), cB + hstep, voffB); PG8_STAGE(PG8_SA(0, 1), cA + hstep, voffA);
        if (wr == 1) PG8_BAR;
        PG8_WAIT_V(4); PG8_BAR;
        PG8_STAGE(PG8_SB(1, 0), cB + kstep, voffB); PG8_STAGE(PG8_SA(1, 0), cA + kstep, voffA); PG8_STAGE(PG8_SB(1, 1), cB + hstep + kstep, voffB);
        PG8_WAIT_V(6); PG8_BAR;
    }
    for (;;) {
        const bool has_next = S.next(ui + 1, nxt);
        const char* nA = has_next ? (const char*)g.A + (size_t)nxt.pm * tstep : cA; const char* nB = has_next ? (const char*)g.Bt + (size_t)nxt.pn * tstep : cB;
        for (int t = 0; t < nt; t += 2) {
            const bool last = (t == nt - 2);
            const char* a1 = cA + (size_t)(t + 1) * kstep;
            const char* a2 = last ? nA : cA + (size_t)(t + 2) * kstep; const char* b2 = last ? nB : cB + (size_t)(t + 2) * kstep;
            const char* a3 = a2 + kstep; const char* b3 = b2 + kstep;
            if (last && has_next) S.a_ready(nxt);
            if constexpr (SP2) {
            PG8_LDB(B0, 0, 0); PG8_LDB(B1, 0, 1); PG8_SCHED; PG8_LDA(At, 0, 0); PG8_STAGE(PG8_SA(1, 1), a1 + hstep, voffA);
            PG8_WAIT_V(8); PG8_WAIT_L(0); PG8_BAR; PG8_MMA(0, 0, At, B0); PG8_MMA(0, 1, At, B1); PG8_BAR; PG8_SCHED;
            PG8_LDA(At, 0, 1); PG8_STAGE(PG8_SB(0, 0), b2, voffB); PG8_STAGE(PG8_SB(0, 1), b2 + hstep, voffB); PG8_STAGE(PG8_SA(0, 0), a2, voffA);
            PG8_WAIT_V(8); PG8_WAIT_L(0); PG8_BAR; PG8_MMA(1, 0, At, B0); PG8_MMA(1, 1, At, B1); PG8_BAR; PG8_SCHED;
            PG8_LDB(B0, 1, 0); PG8_LDB(B1, 1, 1); PG8_SCHED; PG8_LDA(At, 1, 0); PG8_STAGE(PG8_SA(0, 1), a2 + hstep, voffA);
            PG8_WAIT_V(8); PG8_WAIT_L(0); PG8_BAR; PG8_MMA(0, 0, At, B0); PG8_MMA(0, 1, At, B1); PG8_BAR; PG8_SCHED;
            PG8_LDA(At, 1, 1); PG8_STAGE(PG8_SB(1, 0), b3, voffB); PG8_STAGE(PG8_SB(1, 1), b3 + hstep, voffB); PG8_STAGE(PG8_SA(1, 0), a3, voffA);
            PG8_WAIT_V(8); PG8_WAIT_L(0); PG8_BAR; PG8_MMA(1, 0, At, B0); PG8_MMA(1, 1, At, B1); PG8_BAR; PG8_SCHED;
            } else {
            PG8_LDB(B0, 0, 0); PG8_SCHED; PG8_LDA(At, 0, 0); PG8_STAGE(PG8_SA(1, 1), a1 + hstep, voffA);
            PG8_WAIT_L(8); PG8_BAR; PG8_WAIT_L(0); PG8_MMA(0, 0, At, B0); PG8_BAR; PG8_SCHED;
            PG8_LDB(B1, 0, 1); PG8_STAGE(PG8_SB(0, 0), b2, voffB);
            PG8_BAR; PG8_WAIT_L(0); PG8_MMA(0, 1, At, B1); PG8_BAR;
            PG8_LDA(At, 0, 1); PG8_STAGE(PG8_SA(0, 0), a2, voffA);
            PG8_BAR; PG8_WAIT_L(0); PG8_MMA(1, 0, At, B0); PG8_BAR; PG8_SCHED;
            PG8_STAGE(PG8_SB(0, 1), b2 + hstep, voffB);
            PG8_WAIT_V(6); PG8_BAR; PG8_MMA(1, 1, At, B1); PG8_BAR;
            PG8_LDB(B0, 1, 0); PG8_SCHED; PG8_LDA(At, 1, 0); PG8_STAGE(PG8_SA(0, 1), a2 + hstep, voffA);
            PG8_WAIT_L(8); PG8_BAR; PG8_WAIT_L(0); PG8_MMA(0, 0, At, B0); PG8_BAR; PG8_SCHED;
            PG8_LDB(B1, 1, 1); PG8_STAGE(PG8_SB(1, 0), b3, voffB);
            PG8_BAR; PG8_WAIT_L(0); PG8_MMA(0, 1, At, B1); PG8_BAR;
            PG8_LDA(At, 1, 1); PG8_STAGE(PG8_SA(1, 0), a3, voffA);
            PG8_BAR; PG8_WAIT_L(0); PG8_MMA(1, 0, At, B0); PG8_BAR; PG8_SCHED;
            PG8_STAGE(PG8_SB(1, 1), b3 + hstep, voffB);
            PG8_WAIT_V(6); PG8_BAR; PG8_MMA(1, 1, At, B1); PG8_BAR;
            }
        }
        if constexpr (ALIGN_EPI) { if (wr == 0) PG8_BAR; }
        if constexpr (!Epi::AFTER_DRAIN) { E(acc, cur, wr, wc, fr, fq); S.done(cur); }
        if (!has_next) break;
#pragma unroll
        for (int a = 0; a < 2; ++a)
#pragma unroll
            for (int b = 0; b < 2; ++b)
#pragma unroll
                for (int m = 0; m < 4; ++m)
#pragma unroll
                    for (int n = 0; n < 2; ++n) acc[a][b][m][n] = (f32x4){0.f, 0.f, 0.f, 0.f};
        cur = nxt; cA = nA; cB = nB; ++ui;
        if constexpr (ALIGN_EPI) { if (wr == 1) PG8_BAR; }
    }
    PG8_WAIT_V(0);
    if constexpr (!ALIGN_EPI) { if (wr == 0) PG8_BAR; }
    PG8_BAR;
    if constexpr (Epi::AFTER_DRAIN) { E.fused(acc, cur, wr, wc, fr, fq, lds, wid, lane); S.done(cur); }
#undef PG8_SA
#undef PG8_SB
#undef PG8_STAGE
#undef PG8_LDA
#undef PG8_LDB
#undef PG8_MMA
#undef PG8_WAIT_V
#undef PG8_WAIT_L
#undef PG8_BAR
#undef PG8_SCHED
}
}
namespace att {
using bf16 = __hip_bfloat16;
constexpr int D = 128, NW = 8, QBLK = 32, KVBLK = 64;
constexpr float SCALE = 0.088388347648318440f;
constexpr float THR = 8.f;
constexpr int SDEPTH = 2;
constexpr int LDQ = 1024, LDK = 256, LDO = 1024;
constexpr size_t SHM_V = KVBLK * D * 2, SHM_K = KVBLK * D * 2, SHM_ATTN = 2 * SHM_V + 2 * SHM_K + NW * 64 * 4;
using bf16x8 = __attribute__((ext_vector_type(8))) short;
using s16x4  = __attribute__((ext_vector_type(4))) short;
using f32x16 = __attribute__((ext_vector_type(16))) float;
using f32x8  = __attribute__((ext_vector_type(8))) float;
using u32x4  = __attribute__((ext_vector_type(4))) unsigned;
#define KSWZ(row, colB) ((row) * 256 + ((colB) ^ (((row) & 7) << 4)))
#define SBAR() __builtin_amdgcn_sched_barrier(0)
__device__ __forceinline__ int crow(int r, int hi) { return (r & 3) + 8 * (r >> 2) + 4 * hi; }
__device__ __forceinline__ unsigned cvtpk(float lo, float hi) {
  unsigned r; asm volatile("v_cvt_pk_bf16_f32 %0, %1, %2" : "=v"(r) : "v"(lo), "v"(hi)); return r;
}
template <typename TIn> struct Stage;
template <> struct Stage<bf16>  { using T = bf16x8;
  __device__ static __forceinline__ T ld8(const bf16* p) { return *reinterpret_cast<const bf16x8*>(p); }
  __device__ static __forceinline__ bf16x8 tobf(T x) { return x; } };
template <> struct Stage<float> { using T = f32x8;
  __device__ static __forceinline__ T ld8(const float* p) { return *reinterpret_cast<const f32x8*>(p); }
  __device__ static __forceinline__ bf16x8 tobf(T x) {
    u32x4 w = {cvtpk(x[0], x[1]), cvtpk(x[2], x[3]), cvtpk(x[4], x[5]), cvtpk(x[6], x[7])}; return *reinterpret_cast<bf16x8*>(&w); } };

__device__ __forceinline__ void partialSM(f32x16& p0, f32x16& p1, float& m_reg, float& mn, float& alpha) {
  constexpr float C = SCALE * 1.4426950408889634f;
  float pmax = p0[0]; for (int r = 1; r < 16; ++r) pmax = fmaxf(pmax, p0[r]); for (int r = 0; r < 16; ++r) pmax = fmaxf(pmax, p1[r]);
  { auto rr = __builtin_amdgcn_permlane32_swap(__float_as_uint(pmax), __float_as_uint(pmax), false, false);
    pmax = fmaxf(__uint_as_float(rr[0]), __uint_as_float(rr[1])); }
  if (__builtin_expect(__all(pmax - m_reg <= THR / SCALE), 1)) { mn = m_reg; alpha = 1.f; }
  else { mn = fmaxf(m_reg, pmax); alpha = __builtin_amdgcn_exp2f((m_reg - mn) * C); m_reg = mn; }
  float mnC = -mn * C;
  for (int r = 0; r < 16; ++r) p0[r] = fmaf(p0[r], C, mnC); for (int r = 0; r < 16; ++r) p1[r] = fmaf(p1[r], C, mnC);
  for (int r = 0; r < 16; ++r) p0[r] = __builtin_amdgcn_exp2f(p0[r]);
}
__device__ __forceinline__ void finishSM(f32x16& p0, f32x16& p1, float alpha, float& l_reg, bf16x8& pa0, bf16x8& pa1, bf16x8& pa2, bf16x8& pa3) {
  for (int r = 0; r < 16; ++r) p1[r] = __builtin_amdgcn_exp2f(p1[r]);
  float ps = 0; for (int r = 0; r < 16; ++r) ps += p0[r]; for (int r = 0; r < 16; ++r) ps += p1[r];
  { auto rr = __builtin_amdgcn_permlane32_swap(__float_as_uint(ps), __float_as_uint(ps), false, false);
    ps = __uint_as_float(rr[0]) + __uint_as_float(rr[1]); }
  l_reg = l_reg * alpha + ps;
#define PK4(P, BASE, OUT) do { unsigned a0 = cvtpk(P[BASE + 0], P[BASE + 1]), a1 = cvtpk(P[BASE + 2], P[BASE + 3]);   \
    unsigned b0 = cvtpk(P[BASE + 4], P[BASE + 5]), b1 = cvtpk(P[BASE + 6], P[BASE + 7]);                              \
    auto r0 = __builtin_amdgcn_permlane32_swap(a0, b0, false, false); auto r1 = __builtin_amdgcn_permlane32_swap(a1, b1, false, false); \
    u32x4 w = {r0[0], r1[0], r0[1], r1[1]}; OUT = *reinterpret_cast<bf16x8*>(&w); } while (0)
  PK4(p0, 0, pa0); PK4(p0, 8, pa1); PK4(p1, 0, pa2); PK4(p1, 8, pa3);
#undef PK4
}
__device__ __forceinline__ void qkt(f32x16& p0, f32x16& p1, const bf16* Ks, const bf16x8* qr, int r32, int hi) {
  p0 = f32x16{}; p1 = f32x16{};
  for (int d0 = 0; d0 < 8; ++d0) { int cb = (d0 * 16 + hi * 8) * 2;
    bf16x8 b0 = *reinterpret_cast<const bf16x8*>((const char*)Ks + KSWZ(r32, cb));
    bf16x8 b1 = *reinterpret_cast<const bf16x8*>((const char*)Ks + KSWZ(32 + r32, cb));
    p0 = __builtin_amdgcn_mfma_f32_32x32x16_bf16(b0, qr[d0], p0, 0, 0, 0);
    p1 = __builtin_amdgcn_mfma_f32_32x32x16_bf16(b1, qr[d0], p1, 0, 0, 0); }
}
__device__ __forceinline__ int v_st(int k, int c) { const int kk = (k & ~0xC) | ((k & 4) << 1) | ((k & 8) >> 1); return ((kk >> 3) * 4 + (c >> 5)) * 512 + ((kk & 7) * 32 + (c & 31)) * 2; }
__device__ __forceinline__ int v_rd_base(int lane) { return ((lane & 3) << 3) | (((lane >> 2) & 3) << 6) | (((lane >> 4) & 1) << 5) | (((lane >> 5) & 1) << 8); }
constexpr int v_rd_off(int d0, int ks, int half) { return d0 * 512 + ks * 4096 + half * 2048; }
template <int OFF> __device__ __forceinline__ s16x4 tr_read(int vb) {
  s16x4 r; asm volatile("ds_read_b64_tr_b16 %0, %1 offset:%2" : "=&v"(r) : "v"(vb), "i"(OFF) : "memory"); return r;
}
template <int D0> __device__ __forceinline__ void pv_one(f32x16& od, int vb, bf16x8 pa0, bf16x8 pa1, bf16x8 pa2, bf16x8 pa3) {
  const s16x4 l0 = tr_read<v_rd_off(D0, 0, 0)>(vb), h0 = tr_read<v_rd_off(D0, 0, 1)>(vb), l1 = tr_read<v_rd_off(D0, 1, 0)>(vb), h1 = tr_read<v_rd_off(D0, 1, 1)>(vb);
  const s16x4 l2 = tr_read<v_rd_off(D0, 2, 0)>(vb), h2 = tr_read<v_rd_off(D0, 2, 1)>(vb), l3 = tr_read<v_rd_off(D0, 3, 0)>(vb), h3 = tr_read<v_rd_off(D0, 3, 1)>(vb);
  asm volatile("s_waitcnt lgkmcnt(0)" ::: "memory"); SBAR();
#define PK(L, H) (bf16x8){L[0], L[1], L[2], L[3], H[0], H[1], H[2], H[3]}
  od = __builtin_amdgcn_mfma_f32_32x32x16_bf16(pa0, PK(l0, h0), od, 0, 0, 0);
  od = __builtin_amdgcn_mfma_f32_32x32x16_bf16(pa1, PK(l1, h1), od, 0, 0, 0);
  od = __builtin_amdgcn_mfma_f32_32x32x16_bf16(pa2, PK(l2, h2), od, 0, 0, 0);
  od = __builtin_amdgcn_mfma_f32_32x32x16_bf16(pa3, PK(l3, h3), od, 0, 0, 0);
#undef PK
}
__device__ __forceinline__ void pv_d0(f32x16* o, int vb, bf16x8 pa0, bf16x8 pa1, bf16x8 pa2, bf16x8 pa3) {
  pv_one<0>(o[0], vb, pa0, pa1, pa2, pa3); pv_one<1>(o[1], vb, pa0, pa1, pa2, pa3); pv_one<2>(o[2], vb, pa0, pa1, pa2, pa3); pv_one<3>(o[3], vb, pa0, pa1, pa2, pa3);
}

template <typename TQ>
__device__ __forceinline__ void attn_dense_body(const TQ* Qb, const bf16* __restrict__ Kh, const bf16* __restrict__ Vh,
                                                unsigned short* Ob, int seq, char* lds) {
  using St = Stage<bf16>; using SQ = Stage<TQ>;
  const int tid = threadIdx.x, wid = tid >> 6, lane = tid & 63, r32 = lane & 31, hi = lane >> 5;
  bf16* V_lds = (bf16*)lds; bf16* K_lds = (bf16*)(lds + 2 * SHM_V);
  float* ws = (float*)(lds + 2 * SHM_V + 2 * SHM_K) + wid * 64; float* li_l = ws; float* al_l = ws + 32;
  float m_reg = -1e30f, l_reg = 0; f32x16 o[4] = {}; bf16x8 qr[8];
  const TQ* Qw = Qb + (long)(wid * QBLK + r32) * LDQ + hi * 8;
#pragma unroll
  for (int d0 = 0; d0 < 8; ++d0) qr[d0] = SQ::tobf(SQ::ld8(Qw + d0 * 16));
  const int sr = tid >> 4, sc = (tid & 15) * 8, vst0 = v_st(sr, sc), vst1 = v_st(32 + sr, sc);
  const int vb0 = (int)(uintptr_t)V_lds + v_rd_base(lane);
  struct { typename St::T vs0, vs1, ks0, ks1; } sr_[SDEPTH];
#define SLOAD(i, k0) do { sr_[i].vs0 = St::ld8(&Vh[(long)((k0) + sr) * LDK + sc]); sr_[i].vs1 = St::ld8(&Vh[(long)((k0) + 32 + sr) * LDK + sc]); \
    sr_[i].ks0 = St::ld8(&Kh[(long)((k0) + sr) * LDK + sc]); sr_[i].ks1 = St::ld8(&Kh[(long)((k0) + 32 + sr) * LDK + sc]); } while (0)
#define SWRITE(b, i) do { *(bf16x8*)((char*)V_lds + (b) * SHM_V + vst0) = St::tobf(sr_[i].vs0);          \
    *(bf16x8*)((char*)V_lds + (b) * SHM_V + vst1) = St::tobf(sr_[i].vs1); int kc = sc * 2;               \
    *(bf16x8*)((char*)K_lds + (b) * SHM_K + KSWZ(sr, kc)) = St::tobf(sr_[i].ks0);                       \
    *(bf16x8*)((char*)K_lds + (b) * SHM_K + KSWZ(32 + sr, kc)) = St::tobf(sr_[i].ks1); } while (0)
#define SWAIT() do { if constexpr (SDEPTH == 2) asm volatile("s_waitcnt vmcnt(4)" ::: "memory"); else asm volatile("s_waitcnt vmcnt(0)" ::: "memory"); } while (0)
#define RESC(a) do { if (__any((a) < 1.f)) { if (hi == 0) al_l[r32] = (a); asm volatile("s_waitcnt lgkmcnt(0)" ::: "memory"); \
    for (int d = 0; d < 4; ++d) for (int r = 0; r < 16; ++r) o[d][r] *= al_l[crow(r, hi)]; } } while (0)
  f32x16 pA0, pA1, pB0, pB1; float mnA, mnB, alA, alB; bf16x8 pa0, pa1, pa2, pa3; const int NT = seq / KVBLK;
  constexpr int SE = 0, SO = SDEPTH - 1;
  SLOAD(SE, 0); asm volatile("s_waitcnt vmcnt(0)" ::: "memory"); SWRITE(0, SE); __syncthreads();
  qkt(pA0, pA1, K_lds, qr, r32, hi); partialSM(pA0, pA1, m_reg, mnA, alA);
  SLOAD(SO, KVBLK); if constexpr (SDEPTH == 2) { if (2 < NT) SLOAD(SE, 2 * KVBLK); }
  SWAIT(); SWRITE(1, SO); __syncthreads();
  for (int j = 1; j + 1 < NT; j += 2) {
    SBAR(); qkt(pB0, pB1, (bf16*)((char*)K_lds + SHM_K), qr, r32, hi);
    finishSM(pA0, pA1, alA, l_reg, pa0, pa1, pa2, pa3); SBAR();
    SLOAD(SO, (j + SDEPTH) * KVBLK); SBAR();
    pv_d0(o, vb0, pa0, pa1, pa2, pa3); partialSM(pB0, pB1, m_reg, mnB, alB);
    __syncthreads(); SWAIT(); SWRITE(0, SE);
    RESC(alB); __syncthreads();
    SBAR(); qkt(pA0, pA1, K_lds, qr, r32, hi);
    finishSM(pB0, pB1, alB, l_reg, pa0, pa1, pa2, pa3); SBAR();
    if (SDEPTH == 1 || j + 3 < NT) SLOAD(SE, (j + 1 + SDEPTH) * KVBLK); SBAR();
    pv_d0(o, vb0 + (int)SHM_V, pa0, pa1, pa2, pa3); partialSM(pA0, pA1, m_reg, mnA, alA);
    __syncthreads(); SWAIT(); SWRITE(1, SO);
    RESC(alA); __syncthreads();
  }
  SBAR(); qkt(pB0, pB1, (bf16*)((char*)K_lds + SHM_K), qr, r32, hi);
  finishSM(pA0, pA1, alA, l_reg, pa0, pa1, pa2, pa3); SBAR();
  pv_d0(o, vb0, pa0, pa1, pa2, pa3); partialSM(pB0, pB1, m_reg, mnB, alB);
  __syncthreads(); RESC(alB);
  finishSM(pB0, pB1, alB, l_reg, pa0, pa1, pa2, pa3); SBAR();
  pv_d0(o, vb0 + (int)SHM_V, pa0, pa1, pa2, pa3);
  if (hi == 0) li_l[r32] = l_reg; asm volatile("s_waitcnt lgkmcnt(0)" ::: "memory");
  float rli[16];
#pragma unroll
  for (int r = 0; r < 16; ++r) rli[r] = __builtin_amdgcn_rcpf(li_l[crow(r, hi)]);
  unsigned short* Ow = Ob + (long)(wid * QBLK) * LDO;
#pragma unroll
  for (int r = 0; r < 16; ++r) { int orow = crow(r, hi);
    for (int d0 = 0; d0 < 4; ++d0) Ow[(long)orow * LDO + d0 * 32 + r32] = (unsigned short)(cvtpk(o[d0][r] * rli[r], 0.f) & 0xffffu); }
#undef SLOAD
#undef SWRITE
#undef SWAIT
#undef RESC
}
}
namespace ret {
typedef short bf16x8 __attribute__((ext_vector_type(8)));
typedef short s16x4 __attribute__((ext_vector_type(4)));
typedef float f32x16 __attribute__((ext_vector_type(16)));
typedef unsigned u32x4 __attribute__((ext_vector_type(4)));
typedef unsigned u32x2 __attribute__((ext_vector_type(2)));
typedef float f32x2_t __attribute__((ext_vector_type(2))); typedef __bf16 bf16x2_t __attribute__((ext_vector_type(2)));
#define RLAS __attribute__((address_space(3)))
#define RDI __device__ __forceinline__
#define RMFMA(a, b, c) __builtin_amdgcn_mfma_f32_32x32x16_bf16((a), (b), (c), 0, 0, 0)
RDI int crow(int r, int hi) { return (r & 3) + 8 * (r >> 2) + 4 * hi; }
RDI unsigned off_b(unsigned row, unsigned ch) { return 256u * row + 16u * (ch ^ (((row & 3) << 2) | ((row >> 2) & 3))); }
RDI unsigned row_read_addr(unsigned lane, unsigned s) { return off_b(lane & 31, 2 * s + (lane >> 5)); }
RDI unsigned tr_addr(unsigned lane, unsigned c, unsigned ks, unsigned t) { const unsigned h = lane >> 5, blk = (lane >> 4) & 1, q = (lane & 15) >> 2, p = lane & 3; return off_b(16 * ks + 8 * h + 4 * t + q, 4 * c + 2 * blk + (p >> 1)) + 8 * (p & 1); }
RDI unsigned tr_addr_perm(unsigned lane, unsigned c, unsigned ks, unsigned t) { const unsigned h = lane >> 5, blk = (lane >> 4) & 1, q = (lane & 15) >> 2, p = lane & 3; return off_b(16 * ks + 4 * h + 8 * t + q, 4 * c + 2 * blk + (p >> 1)) + 8 * (p & 1); }
typedef short v4i16_t __attribute__((ext_vector_type(4)));
RDI s16x4 vtr(RLAS const unsigned char* p) { return __builtin_bit_cast(s16x4, __builtin_amdgcn_ds_read_tr16_b64_v4i16((RLAS v4i16_t*)p)); }
RDI bf16x8 cat8(s16x4 lo, s16x4 hi) { return __builtin_shufflevector(lo, hi, 0, 1, 2, 3, 4, 5, 6, 7); }
RDI unsigned cvtpk(float lo, float hi) { f32x2_t v = {lo, hi}; bf16x2_t b = __builtin_convertvector(v, bf16x2_t); return __builtin_bit_cast(unsigned, b); }
RDI float blo(unsigned w) { return __builtin_bit_cast(float, w << 16); }
RDI float bhi(unsigned w) { return __builtin_bit_cast(float, w & 0xffff0000u); }
RDI u32x4 scale8(u32x4 v, float s) { u32x4 o; o.x = cvtpk(blo(v.x) * s, bhi(v.x) * s); o.y = cvtpk(blo(v.y) * s, bhi(v.y) * s); o.z = cvtpk(blo(v.z) * s, bhi(v.z) * s); o.w = cvtpk(blo(v.w) * s, bhi(v.w) * s); return o; }

constexpr int PJ_ = 3584;
constexpr int TILE = 8192, IMG = 4 * TILE;

struct StateUnit { const unsigned short* proj; int row0; int nchunks; int h, dir, dvh; float lg2; const float* s0; float* sfin; unsigned short* sbase; int sstride_c; bool store_first; };
__device__ __forceinline__ void ret_state_unit(const StateUnit& U, RLAS unsigned char* lds, int tid, int lane, int wave) {
    const int dkb = wave & 3, dvs = wave >> 2, hi = lane >> 5, l31 = lane & 31;
    RLAS unsigned char* Kimg = lds; RLAS unsigned char* Vimg = lds + IMG;
    f32x16 acc[2];
#pragma unroll
    for (int cc = 0; cc < 2; ++cc) {
        if (U.s0) {
#pragma unroll
            for (int r = 0; r < 16; ++r) acc[cc][r] = U.s0[(size_t)(32 * dkb + crow(r, hi)) * 256 + 128 * U.dvh + 64 * dvs + 32 * cc + l31];
        } else {
#pragma unroll
            for (int r = 0; r < 16; ++r) acc[cc][r] = 0.f;
        }
    }
    const float decay = __builtin_amdgcn_exp2f(128.f * U.lg2);
    u32x4 kreg[4], vreg[4];
    const int srow = tid >> 4, sch = tid & 15;
#define RS_LOAD(c) do { const unsigned short* base_ = U.proj + (size_t)(U.row0 + (c) * 128) * PJ_; \
        _Pragma("unroll") for (int i = 0; i < 4; ++i) { const unsigned short* rp = base_ + (size_t)(srow + 32 * i) * PJ_; \
            kreg[i] = *(const u32x4*)(rp + 512 + U.h * 128 + sch * 8); vreg[i] = *(const u32x4*)(rp + 1024 + U.h * 256 + U.dvh * 128 + sch * 8); } } while (0)
    int c = U.dir == 0 ? 0 : U.nchunks - 1; const int cstep = U.dir == 0 ? 1 : -1;
    RS_LOAD(c);
    for (int step = 0; step < U.nchunks; ++step, c += cstep) {
#pragma unroll
        for (int i = 0; i < 4; ++i) { const int m = srow + 32 * i; const float z = __builtin_amdgcn_exp2f((float)(U.dir == 0 ? 127 - m : m) * U.lg2);
            *(RLAS u32x4*)(Kimg + i * TILE + off_b(srow, sch)) = scale8(kreg[i], z); *(RLAS u32x4*)(Vimg + i * TILE + off_b(srow, sch)) = vreg[i]; }
        __syncthreads();
        if (step + 1 < U.nchunks) RS_LOAD(c + cstep);
        if (step > 0 || U.store_first) {
            unsigned short* sp = U.sbase + (size_t)c * U.sstride_c;
#pragma unroll
            for (int cc = 0; cc < 2; ++cc) { unsigned short* rowp = sp + (size_t)(128 * U.dvh + 64 * dvs + 32 * cc + l31) * 128 + 32 * dkb + 4 * hi;
#pragma unroll
                for (int g = 0; g < 4; ++g) { u32x2 w; w.x = cvtpk(acc[cc][4 * g], acc[cc][4 * g + 1]); w.y = cvtpk(acc[cc][4 * g + 2], acc[cc][4 * g + 3]); *(u32x2*)(rowp + 8 * g) = w; } }
        }
#pragma unroll
        for (int cc = 0; cc < 2; ++cc)
#pragma unroll
            for (int r = 0; r < 16; ++r) acc[cc][r] *= decay;
#pragma unroll
        for (int tb = 0; tb < 4; ++tb)
#pragma unroll
            for (int ks = 0; ks < 2; ++ks) {
                const bf16x8 A = cat8(vtr(Kimg + tb * TILE + tr_addr(lane, dkb, ks, 0)), vtr(Kimg + tb * TILE + tr_addr(lane, dkb, ks, 1)));
#pragma unroll
                for (int cc = 0; cc < 2; ++cc) { const bf16x8 B = cat8(vtr(Vimg + tb * TILE + tr_addr(lane, 2 * dvs + cc, ks, 0)), vtr(Vimg + tb * TILE + tr_addr(lane, 2 * dvs + cc, ks, 1)));
                    acc[cc] = RMFMA(A, B, acc[cc]); }
            }
        __syncthreads();
    }
#undef RS_LOAD
    if (U.sfin) {
#pragma unroll
        for (int cc = 0; cc < 2; ++cc)
#pragma unroll
            for (int r = 0; r < 16; ++r) U.sfin[(size_t)(32 * dkb + crow(r, hi)) * 256 + 128 * U.dvh + 64 * dvs + 32 * cc + l31] = acc[cc][r];
    }
}

struct OutUnit { const unsigned short* proj; int row0; int h; float lgf2, lgb2; const unsigned short* Sf; const unsigned short* Sb; const float* gn; unsigned short* mix; };
__device__ __forceinline__ void ret_out_unit(const OutUnit& U, RLAS unsigned char* lds, RLAS float* red, int tid, int lane, int wave) {
    const int qb = wave & 3, dvh = wave >> 2, hi = lane >> 5, l31 = lane & 31;
    RLAS unsigned char* Qimg = lds; RLAS unsigned char* Kimg = lds + IMG; RLAS unsigned char* Vimg = lds + 2 * IMG + dvh * IMG;
    {
        const unsigned short* base = U.proj + (size_t)U.row0 * PJ_;
        const int srow = tid >> 4, sch = tid & 15;
        u32x4 qreg[4], kreg[4], vreg[8];
#pragma unroll
        for (int i = 0; i < 4; ++i) { const unsigned short* rp = base + (size_t)(srow + 32 * i) * PJ_; qreg[i] = *(const u32x4*)(rp + U.h * 128 + sch * 8); kreg[i] = *(const u32x4*)(rp + 512 + U.h * 128 + sch * 8); }
        const int vrow = tid >> 5, vhalf = (tid >> 4) & 1;
#pragma unroll
        for (int i = 0; i < 8; ++i) { const unsigned short* rp = base + (size_t)(vrow + 16 * i) * PJ_; vreg[i] = *(const u32x4*)(rp + 1024 + U.h * 256 + vhalf * 128 + sch * 8); }
#pragma unroll
        for (int i = 0; i < 4; ++i) { *(RLAS u32x4*)(Qimg + i * TILE + off_b(srow, sch)) = qreg[i]; *(RLAS u32x4*)(Kimg + i * TILE + off_b(srow, sch)) = kreg[i]; }
#pragma unroll
        for (int i = 0; i < 8; ++i) { const int row = vrow + 16 * i; *(RLAS u32x4*)(lds + 2 * IMG + vhalf * IMG + (row >> 5) * TILE + off_b(row & 31, sch)) = vreg[i]; }
    }
    __syncthreads();
    unsigned raddr[8], vaddr[4][2];
#pragma unroll
    for (int s = 0; s < 8; ++s) { raddr[s] = row_read_addr(lane, s); asm volatile("" : "+v"(raddr[s])); }
#pragma unroll
    for (int c = 0; c < 4; ++c)
#pragma unroll
        for (int t = 0; t < 2; ++t) { vaddr[c][t] = tr_addr_perm(lane, c, 0, t); asm volatile("" : "+v"(vaddr[c][t])); }
    bf16x8 qf[8];
#pragma unroll
    for (int s = 0; s < 8; ++s) qf[s] = *(RLAS const bf16x8*)(Qimg + qb * TILE + raddr[s]);
    const int n = 32 * qb + l31;
    f32x16 out[4];
#pragma unroll
    for (int c = 0; c < 4; ++c)
#pragma unroll
        for (int r = 0; r < 16; ++r) out[c][r] = 0.f;
    if (U.Sf) {
        const float xf = __builtin_amdgcn_exp2f((float)(n + 1) * U.lgf2);
        const unsigned short* sp = U.Sf + (size_t)(128 * dvh + l31) * 128 + 8 * hi;
#pragma unroll
        for (int s = 0; s < 8; ++s) { const bf16x8 a = __builtin_bit_cast(bf16x8, scale8(__builtin_bit_cast(u32x4, qf[s]), xf));
            bf16x8 b[4];
#pragma unroll
            for (int c = 0; c < 4; ++c) b[c] = *(const bf16x8*)(sp + (size_t)(32 * c) * 128 + 16 * s);
#pragma unroll
            for (int c = 0; c < 4; ++c) out[c] = RMFMA(a, b[c], out[c]);
            __builtin_amdgcn_sched_barrier(0); }
    }
    if (U.Sb) {
        const float xb = __builtin_amdgcn_exp2f((float)(128 - n) * U.lgb2);
        const unsigned short* sp = U.Sb + (size_t)(128 * dvh + l31) * 128 + 8 * hi;
#pragma unroll
        for (int s = 0; s < 8; ++s) { const bf16x8 a = __builtin_bit_cast(bf16x8, scale8(__builtin_bit_cast(u32x4, qf[s]), xb));
            bf16x8 b[4];
#pragma unroll
            for (int c = 0; c < 4; ++c) b[c] = *(const bf16x8*)(sp + (size_t)(32 * c) * 128 + 16 * s);
#pragma unroll
            for (int c = 0; c < 4; ++c) out[c] = RMFMA(a, b[c], out[c]);
            __builtin_amdgcn_sched_barrier(0); }
    }
#pragma unroll
    for (int kb = 0; kb < 4; ++kb) {
        f32x16 x;
#pragma unroll
        for (int r = 0; r < 16; ++r) x[r] = 0.f;
#pragma unroll
        for (int s = 0; s < 8; ++s) { const bf16x8 kf = *(RLAS const bf16x8*)(Kimg + kb * TILE + raddr[s]); x = RMFMA(kf, qf[s], x); }
#pragma unroll
        for (int r = 0; r < 16; ++r) { const int d = 32 * kb + crow(r, hi) - n;
            const float w = d < 0 ? __builtin_amdgcn_exp2f((float)(-d) * U.lgf2) : (d > 0 ? __builtin_amdgcn_exp2f((float)d * U.lgb2) : 2.f); x[r] *= w; }
        __builtin_amdgcn_sched_barrier(0);
#pragma unroll
        for (int ks = 0; ks < 2; ++ks) { u32x4 p; p.x = cvtpk(x[8 * ks], x[8 * ks + 1]); p.y = cvtpk(x[8 * ks + 2], x[8 * ks + 3]); p.z = cvtpk(x[8 * ks + 4], x[8 * ks + 5]); p.w = cvtpk(x[8 * ks + 6], x[8 * ks + 7]);
            const bf16x8 pa = __builtin_bit_cast(bf16x8, p);
            bf16x8 b[4];
#pragma unroll
            for (int c = 0; c < 4; ++c) b[c] = cat8(vtr(Vimg + kb * TILE + ks * 4096 + vaddr[c][0]), vtr(Vimg + kb * TILE + ks * 4096 + vaddr[c][1]));
#pragma unroll
            for (int c = 0; c < 4; ++c) out[c] = RMFMA(pa, b[c], out[c]);
            __builtin_amdgcn_sched_barrier(0); }
    }
#pragma unroll
    for (int r = 0; r < 16; ++r) { float a = 0.f, b = 0.f;
#pragma unroll
        for (int c = 0; c < 4; ++c) { a += out[c][r]; b += out[c][r] * out[c][r]; }
#pragma unroll
        for (int o = 1; o < 32; o <<= 1) { a += __shfl_xor(a, o); b += __shfl_xor(b, o); }
        if (l31 == 0) { red[((dvh * 128) + 32 * qb + crow(r, hi)) * 2 + 0] = a; red[((dvh * 128) + 32 * qb + crow(r, hi)) * 2 + 1] = b; } }
    __syncthreads();
    const float* gnp = U.gn + U.h * 256 + 128 * dvh + l31;
    float gnv[4];
#pragma unroll
    for (int c = 0; c < 4; ++c) gnv[c] = gnp[32 * c];
#pragma unroll
    for (int r = 0; r < 16; ++r) { const int q = 32 * qb + crow(r, hi);
        const float t1 = red[q * 2] + red[(128 + q) * 2], t2 = red[q * 2 + 1] + red[(128 + q) * 2 + 1];
        const float mu = t1 * (1.f / 256.f); float var = t2 * (1.f / 256.f) - mu * mu; var = var < 0.f ? 0.f : var;
        const float rs = 1.f / sqrtf(var + 1e-6f);
        const size_t R = (size_t)(U.row0 + q);
        const unsigned short* gp = U.proj + R * PJ_ + 2048 + U.h * 256 + 128 * dvh + l31; unsigned short* mp = U.mix + R * 1536 + U.h * 256 + 128 * dvh + l31;
#pragma unroll
        for (int c = 0; c < 4; ++c) { const float g = blo((unsigned)gp[32 * c]); const float y = (out[c][r] - mu) * rs * gnv[c];
            const float v = g * __builtin_amdgcn_rcpf(1.f + __builtin_amdgcn_exp2f(-1.4426950408889634f * g)) * y; mp[32 * c] = (unsigned short)(cvtpk(v, 0.f) & 0xffffu); }
        __builtin_amdgcn_sched_barrier(0);
    }
    __syncthreads();
}
#undef RLAS
#undef RDI
#undef RMFMA
}
constexpr int DM = 1024, NPROW = 8192, M = 16384;
constexpr int PT = 256, ST = 2048, PAST = 512;
constexpr int PJ = 3584, MIXW = 1536, DFF = 2816, QKVN = 1536;
constexpr int KVSEQ_S = PAST + ST;
constexpr float EPS = 1e-6f;
constexpr size_t OUT_Y = 0, OUT_STATE = 16777216, OUT_CK = 25165824, OUT_CV = 27262976;

constexpr size_t MiB = 1u << 20;
constexpr size_t WS_CTL = 0, CTL_ZERO_BYTES = 1 * MiB;
constexpr size_t WS_MOD = 1 * MiB;
constexpr size_t WS_WIN = 2 * MiB, WS_WOUT = 9 * MiB, WS_WF1_0 = 12 * MiB, WS_WF2_0 = 23 * MiB, WS_POOLW = 28 * MiB + 512 * 1024;
constexpr size_t WS_HM = 30 * MiB;
constexpr size_t WS_PROJ = 78 * MiB;
constexpr size_t WS_S = 190 * MiB;
constexpr size_t WS_OF32 = 78 * MiB;
constexpr size_t WS_WQKV = 142 * MiB, WS_WO = 145 * MiB, WS_WF1_1 = 147 * MiB, WS_WF2_1 = 158 * MiB;
constexpr size_t WS_HID = 164 * MiB;
constexpr size_t WS_QKVRAW = 78 * MiB;
constexpr size_t WS_Q = 164 * MiB;
constexpr size_t WS_K = 238 * MiB, WS_V = 247 * MiB;
constexpr size_t WS_END = 256 * MiB;
constexpr int CW_BAR = 4096;

constexpr int NWAVES = 8;
constexpr int RING_BYTES = 131072, LDSCTL_OFF = RING_BYTES, MISC_OFF = LDSCTL_OFF + 320, LDS_BYTES = 147456;

#ifndef MK_N_LAUNCHES
#define MK_N_LAUNCHES 1
#endif
constexpr int NPHASES = 18;

#define GAS __attribute__((address_space(1)))
#define LAS __attribute__((address_space(3)))
typedef unsigned short bf16;
typedef unsigned v4u __attribute__((ext_vector_type(4)));
typedef unsigned v2u __attribute__((ext_vector_type(2)));
typedef float f32x4 __attribute__((ext_vector_type(4)));
#define LDS_WAIT() asm volatile("s_waitcnt lgkmcnt(0)" ::: "memory")
#define VM_WAIT() asm volatile("s_waitcnt vmcnt(0)" ::: "memory")
__device__ __forceinline__ unsigned f2bf(float f) { unsigned u = __builtin_bit_cast(unsigned, f); return (u + 0x7fffu + ((u >> 16) & 1u)) >> 16; }
__device__ __forceinline__ unsigned pk2(float lo, float hi) { return f2bf(lo) | (f2bf(hi) << 16); }
__device__ __forceinline__ float bf2f(unsigned h) { return __builtin_bit_cast(float, h << 16); }
__device__ __forceinline__ float bflo(unsigned w) { return __builtin_bit_cast(float, w << 16); }
__device__ __forceinline__ float bfhi(unsigned w) { return __builtin_bit_cast(float, w & 0xffff0000u); }
__device__ __forceinline__ float wave_sum(float v) {
#pragma unroll
    for (int o = 1; o < 64; o <<= 1) v += __shfl_xor(v, o);
    return v;
}
__device__ __forceinline__ float log_sigmoid(float x) { return x >= 0.f ? -log1pf(expf(-x)) : x - log1pf(expf(x)); }

typedef GAS unsigned gu32;
typedef GAS unsigned long long gu64;
#define RLX_AGENT __ATOMIC_RELAXED, __HIP_MEMORY_SCOPE_AGENT
#define XB_TMO      128
#define XB_XCNT(j)  (256  + 64 * (j))
#define XB_XSUB(j)  (1280 + 64 * (j))
#define XB_XGEN(j)  (2304 + 64 * (j))
#define XB_TOP      3328
#define XB_TOPGEN   3392
#define XCD_BAR_WORDS 3456
#define XB_SPIN_CAP (1u << 18)

__device__ __forceinline__ unsigned xb_ld(unsigned* p)              { return __hip_atomic_load(p, __ATOMIC_RELAXED, __HIP_MEMORY_SCOPE_AGENT); }
__device__ __forceinline__ unsigned xb_add(unsigned* p, unsigned v) { return __hip_atomic_fetch_add(p, v, __ATOMIC_RELAXED, __HIP_MEMORY_SCOPE_AGENT); }
__device__ __forceinline__ unsigned xb_xcc_id() { return (unsigned)__builtin_amdgcn_s_getreg((3 << 11) | 20) & 0xFu; }
#define XB_SPIN(cond, bar) do { unsigned _sp = 0; while (cond) { __builtin_amdgcn_s_sleep(1); \
    if ((++_sp & 255u) == 0u) { if (xb_ld(&(bar)[XB_TMO])) break; if (_sp > XB_SPIN_CAP) { atomicAdd(&(bar)[XB_TMO], 1u); break; } } } } while (0)

struct XcdBarrier {
    unsigned* bar; unsigned x;
    volatile LAS unsigned* st;
};

__device__ __forceinline__ XcdBarrier xcd_barrier_post(unsigned* bar, volatile LAS unsigned* st) {
    XcdBarrier b; b.bar = bar; b.x = xb_xcc_id(); b.st = st;
    if (threadIdx.x == 0) (void)xb_add(&bar[XB_XCNT(b.x)], 1u);
    return b;
}
__device__ __forceinline__ void xcd_barrier_complete(unsigned* bar, unsigned x, unsigned& nloc, unsigned& nx) {
    const unsigned G = gridDim.x * gridDim.y * gridDim.z;
    unsigned sum, cnt, mine, sp = 0u;
    for (;;) {
        sum = 0u; cnt = 0u; mine = 0u;
#pragma unroll
        for (unsigned j = 0; j < 16; ++j) { const unsigned c = xb_ld(&bar[XB_XCNT(j)]); sum += c; cnt += (c > 0u) ? 1u : 0u; mine = (j == x) ? c : mine; }
        if (sum == G) break;
        __builtin_amdgcn_s_sleep(1);
        if ((++sp & 255u) == 0u) { if (xb_ld(&bar[XB_TMO])) break; if (sp > XB_SPIN_CAP) { atomicAdd(&bar[XB_TMO], 1u); break; } }
    }
    nloc = mine > 0u ? mine : 1u; nx = cnt > 0u ? cnt : 1u;
}

__device__ __forceinline__ void xcd_barrier(const XcdBarrier& b) {
    asm volatile("s_waitcnt vmcnt(0)" ::: "memory");
    __syncthreads();
    if (threadIdx.x == 0) {
        unsigned* bar = b.bar;
        __builtin_amdgcn_s_waitcnt(0);
        unsigned nloc = b.st[0], nx = b.st[1];
        if (nloc == 0u) { xcd_barrier_complete(bar, b.x, nloc, nx); b.st[0] = nloc; b.st[1] = nx; }
        const unsigned old = xb_add(&bar[XB_XSUB(b.x)], 1u);
        const unsigned gen = old / nloc;
        if (old + 1u == (gen + 1u) * nloc) {
            __builtin_amdgcn_fence(__ATOMIC_RELEASE, "agent");
            asm volatile("s_waitcnt vmcnt(0)" ::: "memory");
            const unsigned og = xb_add(&bar[XB_TOP], 1u);
            const unsigned tg = og / nx;
            if (og + 1u == (tg + 1u) * nx) xb_add(&bar[XB_TOPGEN], 1u);
            else XB_SPIN(xb_ld(&bar[XB_TOPGEN]) == tg, bar);
            __builtin_amdgcn_fence(__ATOMIC_ACQUIRE, "agent");
            xb_add(&bar[XB_XGEN(b.x)], 1u);
            asm volatile("s_waitcnt vmcnt(0)" ::: "memory");
        } else {
            XB_SPIN(xb_ld(&bar[XB_XGEN(b.x)]) == gen, bar);
            __builtin_amdgcn_fence(__ATOMIC_ACQUIRE, "agent");
            asm volatile("s_waitcnt vmcnt(0)" ::: "memory");
        }
    }
    __syncthreads();
}


struct Args { const float* in[22]; float* out; unsigned char* ws; int ph_lo, ph_hi; };

__device__ __forceinline__ int row_type(int row) { return row < NPROW ? 0 : 1 + ((row - NPROW) >> 11); }
__device__ __forceinline__ const float* mod_ptr(const Args& a, int layer, int row, int chunk) { return (const float*)(a.ws + WS_MOD) + (size_t)(layer * 5 + row_type(row)) * 6144 + chunk * 1024; }
__device__ __forceinline__ const float* x_in_row(const Args& a, int row) { return row < NPROW ? a.in[0] + (size_t)row * DM : a.in[1] + (size_t)(row - NPROW) * DM; }

template <int MAP> __device__ __forceinline__ int wmap(int n) { if (MAP == 2) { const int j = n < DFF ? n : n - DFF; return (j >> 7) * 256 + (j & 127) + (n < DFF ? 0 : 128); } return n; }
template <int MAP> __device__ __forceinline__ float wscale(int n) { if (MAP == 1) return n < 512 ? 0.08838834764831845f : 1.f; return 1.f; }
template <int MAP> __device__ __forceinline__ void wconv_item(const float* W, int K, int N, bf16* WT, LAS float* scr, int item, int lane) {
    const int nblk = N / 32, kb = item / nblk, nb = item % nblk, k0 = 64 * kb, n0 = 32 * nb;
#pragma unroll 8
    for (int i = 0; i < 32; ++i) { const int kk = 2 * i + (lane >> 5); scr[kk * 33 + (lane & 31)] = W[(size_t)(k0 + kk) * N + n0 + (lane & 31)]; }
    LDS_WAIT(); asm volatile("" ::: "memory");
    const int c = lane & 7;
#pragma unroll
    for (int j = 0; j < 4; ++j) { const int n = (lane >> 3) + 8 * j; const LAS float* s = scr + (8 * c) * 33 + n; const float sc = wscale<MAP>(n0 + n);
        v4u o; o.x = pk2(s[0 * 33] * sc, s[1 * 33] * sc); o.y = pk2(s[2 * 33] * sc, s[3 * 33] * sc); o.z = pk2(s[4 * 33] * sc, s[5 * 33] * sc); o.w = pk2(s[6 * 33] * sc, s[7 * 33] * sc);
        *(v4u*)(WT + (size_t)wmap<MAP>(n0 + n) * K + k0 + 8 * c) = o; }
    LDS_WAIT(); asm volatile("" ::: "memory");
}

__device__ __forceinline__ void ph_prologue(const Args& a, LAS unsigned char* lds, int tid, int lane, int wave, int gw, int NGW) {
    if (blockIdx.x < 192) {
        const int item = blockIdx.x, l = item / 96, n0 = (item % 96) * 64;
        LAS float* sv = (LAS float*)lds;
        LAS float* part = (LAS float*)(lds + 32768);
        for (int i = tid; i < 5 * 1024; i += 512) { const int r = i >> 10, k = i & 1023; const float c = r == 0 ? a.in[6][k] : a.in[5][(r - 1) * 1024 + k]; sv[i] = c / (1.f + expf(-c)); }
        __syncthreads();
        float acc[5] = {0.f, 0.f, 0.f, 0.f, 0.f};
        const float* wp = a.in[7] + ((size_t)l * 1024 + wave * 128) * 6144 + n0 + lane;
#pragma unroll 8
        for (int k = 0; k < 128; ++k) { const float wv = wp[(size_t)k * 6144];
#pragma unroll
            for (int r = 0; r < 5; ++r) acc[r] += sv[r * 1024 + wave * 128 + k] * wv; }
#pragma unroll
        for (int r = 0; r < 5; ++r) part[(wave * 5 + r) * 64 + lane] = acc[r];
        __syncthreads();
        if (tid < 320) { const int r = tid >> 6, ln = tid & 63; float s = a.in[8][l * 6144 + n0 + ln];
#pragma unroll
            for (int w = 0; w < 8; ++w) s += part[(w * 5 + r) * 64 + ln];
            ((float*)(a.ws + WS_MOD))[(size_t)(l * 5 + r) * 6144 + n0 + ln] = s; }
        __syncthreads();
    }
    LAS float* scr = (LAS float*)(lds + wave * 16384);
    constexpr int I_IN = 16 * (PJ / 32), I_OUT = 24 * 32, I_F1 = 16 * (2 * DFF / 32), I_F2 = 44 * 32;
    for (int it = gw; it < I_IN + I_OUT + I_F1 + I_F2; it += NGW) {
        int r = it;
        if (r < I_IN) { wconv_item<1>(a.in[12], 1024, PJ, (bf16*)(a.ws + WS_WIN), scr, r, lane); continue; } r -= I_IN;
        if (r < I_OUT) { wconv_item<0>(a.in[17], MIXW, 1024, (bf16*)(a.ws + WS_WOUT), scr, r, lane); continue; } r -= I_OUT;
        if (r < I_F1) { wconv_item<2>(a.in[10], 1024, 2 * DFF, (bf16*)(a.ws + WS_WF1_0), scr, r, lane); continue; } r -= I_F1;
        wconv_item<0>(a.in[11], DFF, 1024, (bf16*)(a.ws + WS_WF2_0), scr, r, lane);
    }
}
__device__ __forceinline__ void job_wconv_l1(const Args& a, LAS unsigned char* lds, int lane, int wave, int gw, int NGW) {
    LAS float* scr = (LAS float*)(lds + wave * 16384);
    constexpr int I_QKV = 16 * (QKVN / 32), I_O = 16 * 32, I_F1 = 16 * (2 * DFF / 32), I_F2 = 44 * 32;
    for (int it = gw; it < I_QKV + I_O + I_F1 + I_F2; it += NGW) {
        int r = it;
        if (r < I_QKV) { wconv_item<0>(a.in[18], 1024, QKVN, (bf16*)(a.ws + WS_WQKV), scr, r, lane); continue; } r -= I_QKV;
        if (r < I_O) { wconv_item<0>(a.in[21], 1024, 1024, (bf16*)(a.ws + WS_WO), scr, r, lane); continue; } r -= I_O;
        if (r < I_F1) { wconv_item<2>(a.in[10] + (size_t)1024 * 2 * DFF, 1024, 2 * DFF, (bf16*)(a.ws + WS_WF1_1), scr, r, lane); continue; } r -= I_F1;
        wconv_item<0>(a.in[11] + (size_t)DFF * 1024, DFF, 1024, (bf16*)(a.ws + WS_WF2_1), scr, r, lane);
    }
}
__device__ __forceinline__ void job_cache_conv(const Args& a, int gtid, int NT) {
    bf16* Kb = (bf16*)(a.ws + WS_K); bf16* Vb = (bf16*)(a.ws + WS_V);
    for (int i = gtid; i < 4 * PAST * 256 / 4; i += NT) {
        const int e = i * 4, bs = e / (PAST * 256), rem = e % (PAST * 256);
        const f32x4 k = *(const f32x4*)(a.in[3] + e), v = *(const f32x4*)(a.in[4] + e);
        const size_t d = (size_t)(NPROW + bs * KVSEQ_S) * 256 + rem;
        v2u ko, vo; ko.x = pk2(k.x, k.y); ko.y = pk2(k.z, k.w); vo.x = pk2(v.x, v.y); vo.y = pk2(v.z, v.w);
        *(v2u*)(Kb + d) = ko; *(v2u*)(Vb + d) = vo;
    }
}

__device__ __forceinline__ void normmod_row(const float* xrow, const float* gain, const float* sc, const float* sh, bf16* orow, int lane) {
    f32x4 v[4]; float s = 0.f;
#pragma unroll
    for (int j = 0; j < 4; ++j) { v[j] = ((const f32x4*)xrow)[lane + 64 * j]; s += (v[j].x * v[j].x + v[j].y * v[j].y) + (v[j].z * v[j].z + v[j].w * v[j].w); }
    const float rstd = 1.f / sqrtf(wave_sum(s) * (1.f / DM) + EPS);
#pragma unroll
    for (int j = 0; j < 4; ++j) { const f32x4 g = ((const f32x4*)gain)[lane + 64 * j], c = ((const f32x4*)sc)[lane + 64 * j], h = ((const f32x4*)sh)[lane + 64 * j];
        const f32x4 y = (v[j] * rstd * g) * (c + 1.f) + h; v2u o; o.x = pk2(y.x, y.y); o.y = pk2(y.z, y.w); ((v2u*)orow)[lane + 64 * j] = o; }
}
__device__ __forceinline__ void resid_row(const float* xrow, const float* orow, const float* gA, const float* gate, float* xo, const float* gB, const float* sc, const float* sh, bf16* hrow, int lane) {
    f32x4 x[4], o[4]; float s = 0.f;
#pragma unroll
    for (int j = 0; j < 4; ++j) { x[j] = ((const f32x4*)xrow)[lane + 64 * j]; o[j] = ((const f32x4*)orow)[lane + 64 * j]; s += (o[j].x * o[j].x + o[j].y * o[j].y) + (o[j].z * o[j].z + o[j].w * o[j].w); }
    const float rstd = 1.f / sqrtf(wave_sum(s) * (1.f / DM) + EPS);
    float s1 = 0.f;
#pragma unroll
    for (int j = 0; j < 4; ++j) { const f32x4 g = ((const f32x4*)gA)[lane + 64 * j], gt = ((const f32x4*)gate)[lane + 64 * j];
        x[j] = x[j] + gt * (o[j] * rstd * g); ((f32x4*)xo)[lane + 64 * j] = x[j]; s1 += (x[j].x * x[j].x + x[j].y * x[j].y) + (x[j].z * x[j].z + x[j].w * x[j].w); }
    if (hrow) {
        const float rstd1 = 1.f / sqrtf(wave_sum(s1) * (1.f / DM) + EPS);
#pragma unroll
        for (int j = 0; j < 4; ++j) { const f32x4 g = ((const f32x4*)gB)[lane + 64 * j], c = ((const f32x4*)sc)[lane + 64 * j], h = ((const f32x4*)sh)[lane + 64 * j];
            const f32x4 y = (x[j] * rstd1 * g) * (c + 1.f) + h; v2u w; w.x = pk2(y.x, y.y); w.y = pk2(y.z, y.w); ((v2u*)hrow)[lane + 64 * j] = w; }
    }
}

__device__ __forceinline__ void naive_ret_state(const Args& a, int item, int tid) {
    const int b = item >> 3, h = (item >> 1) & 3, dir = item & 1;
    const float lg = log_sigmoid(a.in[13][dir * 4 + h]);
    const int dv = tid & 255, dkh = tid >> 8;
    const bf16* P = (const bf16*)(a.ws + WS_PROJ);
    float acc[64];
#pragma unroll
    for (int i = 0; i < 64; ++i) acc[i] = 0.f;
    for (int t = 0; t < PT; ++t) {
        const bf16* pr = P + (size_t)(b * PT + t) * PJ;
        const float vv = bf2f(pr[1024 + h * 256 + dv]) * expf(lg * (float)(dir == 0 ? (PT - 1 - t) : t));
        const v4u* kp = (const v4u*)(pr + 512 + h * 128 + dkh * 64);
#pragma unroll
        for (int i8 = 0; i8 < 8; ++i8) { const v4u kk = kp[i8];
            acc[i8 * 8 + 0] += bflo(kk.x) * vv; acc[i8 * 8 + 1] += bfhi(kk.x) * vv; acc[i8 * 8 + 2] += bflo(kk.y) * vv; acc[i8 * 8 + 3] += bfhi(kk.y) * vv;
            acc[i8 * 8 + 4] += bflo(kk.z) * vv; acc[i8 * 8 + 5] += bfhi(kk.z) * vv; acc[i8 * 8 + 6] += bflo(kk.w) * vv; acc[i8 * 8 + 7] += bfhi(kk.w) * vv; }
    }
    float* o = a.out + OUT_STATE + ((size_t)((b * 2 + dir) * 4 + h) * 128 + dkh * 64) * 256 + dv;
#pragma unroll
    for (int i = 0; i < 64; ++i) o[(size_t)i * 256] = acc[i];
}
__device__ __forceinline__ void seq_of_row(int R, int& s0, int& T) { if (R < NPROW) { s0 = R & ~(PT - 1); T = PT; } else { s0 = NPROW + ((R - NPROW) & ~(ST - 1)); T = ST; } }
__device__ __forceinline__ void naive_pool(const Args& a, LAS unsigned char* lds, int item, int tid) {
    const int tile = item >> 2, g = item & 3, R0 = tile * 64, half = 1 << g;
    const bf16* P = (const bf16*)(a.ws + WS_PROJ); bf16* mix = (bf16*)(a.ws + WS_HM);
    LAS float* d = (LAS float*)lds;
    for (int e = tid; e < 64 * 128; e += 512) { const int r = e >> 7, c = e & 127, R = R0 + r; int s0, T; seq_of_row(R, s0, T); const int t = R - s0;
        const int lo = t - half < 0 ? 0 : t - half, hi = t + half > T ? T : t + half; float s = 0.f;
        for (int tt = lo; tt < hi; ++tt) s += bf2f(P[(size_t)(s0 + tt) * PJ + 3072 + g * 128 + c]);
        d[e] = s / (float)(hi - lo) - bf2f(P[(size_t)R * PJ + 3072 + g * 128 + c]); }
    __syncthreads();
    const int e = tid & 127, rg = tid >> 7; float acc[16];
#pragma unroll
    for (int i = 0; i < 16; ++i) acc[i] = 0.f;
    const float* pw = a.in[15] + (size_t)g * 128 * 128 + e;
    for (int c = 0; c < 128; ++c) { const float w = pw[c * 128];
#pragma unroll
        for (int i = 0; i < 16; ++i) acc[i] += d[(rg + 4 * i) * 128 + c] * w; }
    const float ps = a.in[16][g * 128 + e];
#pragma unroll
    for (int i = 0; i < 16; ++i) mix[(size_t)(R0 + rg + 4 * i) * MIXW + 1024 + g * 128 + e] = (bf16)f2bf(acc[i] * ps);
    __syncthreads();
}
__device__ __forceinline__ void naive_ret_out(const Args& a, LAS unsigned char* lds, int item, int lane, int wave) {
    const int R = item >> 2, h = item & 3; int s0, T; seq_of_row(R, s0, T); const int t = R - s0;
    const float lgf = log_sigmoid(a.in[13][h]), lgb = log_sigmoid(a.in[13][4 + h]);
    const bf16* P = (const bf16*)(a.ws + WS_PROJ); bf16* mix = (bf16*)(a.ws + WS_HM);
    LAS float* wsm = (LAS float*)(lds + wave * 8704); LAS float* qs = wsm + 2048;
    LDS_WAIT();
    qs[lane] = bf2f(P[(size_t)R * PJ + h * 128 + lane]); qs[lane + 64] = bf2f(P[(size_t)R * PJ + h * 128 + 64 + lane]);
    LDS_WAIT(); asm volatile("" ::: "memory");
    for (int tp = lane; tp < T; tp += 64) {
        const v4u* kp = (const v4u*)(P + (size_t)(s0 + tp) * PJ + 512 + h * 128); float dot = 0.f;
#pragma unroll
        for (int i8 = 0; i8 < 16; ++i8) { const v4u kk = kp[i8]; const LAS float* q = qs + i8 * 8;
            dot += bflo(kk.x) * q[0] + bfhi(kk.x) * q[1] + bflo(kk.y) * q[2] + bfhi(kk.y) * q[3] + bflo(kk.z) * q[4] + bfhi(kk.z) * q[5] + bflo(kk.w) * q[6] + bfhi(kk.w) * q[7]; }
        const float w = tp < t ? expf(lgf * (float)(t - tp)) : (tp > t ? expf(lgb * (float)(tp - t)) : 2.f);
        wsm[tp] = dot * w;
    }
    LDS_WAIT(); asm volatile("" ::: "memory");
    float y[4] = {0.f, 0.f, 0.f, 0.f};
    const bf16* vp = P + (size_t)s0 * PJ + 1024 + h * 256 + 4 * lane;
#pragma unroll 8
    for (int tp = 0; tp < T; ++tp) { const float s = wsm[tp]; const v2u vv = *(const v2u*)(vp + (size_t)tp * PJ);
        y[0] += s * bflo(vv.x); y[1] += s * bfhi(vv.x); y[2] += s * bflo(vv.y); y[3] += s * bfhi(vv.y); }
    if (R >= NPROW) {
        const int bs = (R - NPROW) >> 11; const float cf = expf(lgf * (float)(t + 1)), cb = expf(lgb * (float)(T - t));
        const float* sf = a.in[2] + ((size_t)((bs * 2 + 0) * 4 + h) * 128) * 256 + 4 * lane; const float* sb = a.in[2] + ((size_t)((bs * 2 + 1) * 4 + h) * 128) * 256 + 4 * lane;
#pragma unroll 4
        for (int dk = 0; dk < 128; ++dk) { const float qf = qs[dk] * cf, qb = qs[dk] * cb; const f32x4 A = *(const f32x4*)(sf + (size_t)dk * 256), B = *(const f32x4*)(sb + (size_t)dk * 256);
            y[0] += qf * A.x + qb * B.x; y[1] += qf * A.y + qb * B.y; y[2] += qf * A.z + qb * B.z; y[3] += qf * A.w + qb * B.w; }
    }
    const float mu = wave_sum((y[0] + y[1]) + (y[2] + y[3])) * (1.f / 256.f);
    const float d0 = y[0] - mu, d1 = y[1] - mu, d2 = y[2] - mu, d3 = y[3] - mu;
    const float var = wave_sum((d0 * d0 + d1 * d1) + (d2 * d2 + d3 * d3)) * (1.f / 256.f);
    const float rs = 1.f / sqrtf(var + EPS);
    const f32x4 gn = *(const f32x4*)(a.in[14] + h * 256 + 4 * lane);
    const v2u gg = *(const v2u*)(P + (size_t)R * PJ + 2048 + h * 256 + 4 * lane);
    const float g0 = bflo(gg.x), g1 = bfhi(gg.x), g2 = bflo(gg.y), g3 = bfhi(gg.y);
    const float o0 = (g0 / (1.f + expf(-g0))) * (d0 * rs * gn.x), o1 = (g1 / (1.f + expf(-g1))) * (d1 * rs * gn.y), o2 = (g2 / (1.f + expf(-g2))) * (d2 * rs * gn.z), o3 = (g3 / (1.f + expf(-g3))) * (d3 * rs * gn.w);
    v2u w; w.x = pk2(o0, o1); w.y = pk2(o2, o3);
    *(v2u*)(mix + (size_t)R * MIXW + h * 256 + 4 * lane) = w;
}
__device__ __forceinline__ int kv_row(int R) { return R < NPROW ? R : NPROW + ((R - NPROW) >> 11) * KVSEQ_S + PAST + ((R - NPROW) & (ST - 1)); }
__device__ __forceinline__ void naive_qkv_post(const Args& a, int item, int lane) {
    const int R = item / 12, slot = item % 12;
    const bf16* raw = (const bf16*)(a.ws + WS_QKVRAW) + (size_t)R * QKVN;
    const int da = (lane >> 5) * 64 + (lane & 31), db = da + 32;
    if (slot >= 10) {
        const int kvh = slot - 10; const float va = bf2f(raw[1280 + kvh * 128 + da]), vb = bf2f(raw[1280 + kvh * 128 + db]);
        bf16* Vb = (bf16*)(a.ws + WS_V) + (size_t)kv_row(R) * 256 + kvh * 128; Vb[da] = raw[1280 + kvh * 128 + da]; Vb[db] = raw[1280 + kvh * 128 + db];
        if (R < NPROW) { float* o = a.out + OUT_CV + (size_t)R * 256 + kvh * 128; o[da] = va; o[db] = vb; }
        return;
    }
    const bool isq = slot < 8; const int src = isq ? slot * 128 : 1024 + (slot - 8) * 128;
    const float xa = bf2f(raw[src + da]), xb = bf2f(raw[src + db]);
    const float rstd = 1.f / sqrtf(wave_sum(xa * xa + xb * xb) * (1.f / 128.f) + EPS);
    const float* gain = isq ? a.in[19] : a.in[20];
    float ya = xa * rstd * gain[da], yb = xb * rstd * gain[db];
    if (!isq && R < NPROW) { float* o = a.out + OUT_CK + (size_t)R * 256 + (slot - 8) * 128; o[da] = ya; o[db] = yb; }
    if (R >= NPROW) {
        const int t = (R - NPROW) & (ST - 1); const float pos = (float)((lane >> 5) ? (t & 63) : (t >> 6));
        const float fr = expf(-(float)(lane & 31) * (9.210340371976184f / 32.f)); const float ang = pos * fr; const float c = cosf(ang), s = sinf(ang);
        const float ra = ya * c - yb * s, rb = yb * c + ya * s; ya = ra; yb = rb;
    }
    if (isq) { bf16* Q = (bf16*)(a.ws + WS_Q) + (size_t)R * 1024 + slot * 128; Q[da] = (bf16)f2bf(ya); Q[db] = (bf16)f2bf(yb); }
    else { bf16* Kb = (bf16*)(a.ws + WS_K) + (size_t)kv_row(R) * 256 + (slot - 8) * 128; Kb[da] = (bf16)f2bf(ya); Kb[db] = (bf16)f2bf(yb); }
}

__global__ void __launch_bounds__(NWAVES * 64, 2) skel_fwd(Args a) {
    extern __shared__ __attribute__((aligned(16))) unsigned char lds_raw[];
    LAS unsigned char* lds = (LAS unsigned char*)lds_raw;
    volatile LAS unsigned* MISC = (volatile LAS unsigned*)(lds + MISC_OFF);
    const int tid = threadIdx.x, lane = tid & 63, wave = __builtin_amdgcn_readfirstlane(tid >> 6);
    const int G = gridDim.x, bx = blockIdx.x;
    const int vcu = (G % 8 == 0) ? (bx % 8) * (G / 8) + bx / 8 : bx;
    const int gw = vcu * NWAVES + wave, NGW = G * NWAVES;
    gu32* ctl = (gu32*)(a.ws + WS_CTL);
    for (int u = tid; u < (LDS_BYTES - LDSCTL_OFF) / 4; u += NWAVES * 64) ((LAS unsigned*)(lds + LDSCTL_OFF))[u] = 0u;
    __syncthreads();
    XcdBarrier bar; bar.bar = (unsigned*)(ctl + CW_BAR); bar.x = 0; bar.st = nullptr;
    if (MK_N_LAUNCHES == 1) bar = xcd_barrier_post((unsigned*)(ctl + CW_BAR), MISC + 8);
    const int lo = a.ph_lo, hi = a.ph_hi;
#define IN(k) (lo <= (k) && (k) < hi)
#define SEAM(k) do { if (IN(k) && IN((k) + 1)) xcd_barrier(bar); } while (0)

    bf16* H = (bf16*)(a.ws + WS_HM); bf16* MIX = (bf16*)(a.ws + WS_HM); bf16* PROJ = (bf16*)(a.ws + WS_PROJ); float* OF32 = (float*)(a.ws + WS_OF32);
    bf16* HID = (bf16*)(a.ws + WS_HID); float* Y = a.out + OUT_Y;
    const float* ng = a.in[9];

    if (IN(0)) { ph_prologue(a, lds, tid, lane, wave, gw, NGW); } SEAM(0);
    if (IN(1)) { for (int m = gw; m < M; m += NGW) normmod_row(x_in_row(a, m), ng + 0 * 1024, mod_ptr(a, 0, m, 1), mod_ptr(a, 0, m, 0), H + (size_t)m * DM, lane); } SEAM(1);
    if (IN(2)) { pg8::Gemm g{H, (const bf16*)(a.ws + WS_WIN), M, PJ, 1024}; pg8::StaticOrder S; S.init(M, PJ, G, bx); pg8::EpiBf16P E{PROJ, PJ};
        pg8::gemm_phase<pg8::EpiBf16P, pg8::StaticOrder, true, true>(lds, g, S, E); } SEAM(2);
    if (IN(3)) {
        const float L2E = 1.4426950408889634f; bf16* SB = (bf16*)(a.ws + WS_S);
        int tid = threadIdx.x; asm volatile("" : "+v"(tid)); const int lane = tid & 63;
        if (bx < 64) { const int bs = bx >> 4, h = (bx >> 2) & 3, dir = (bx >> 1) & 1, dvh = bx & 1;
            ret::StateUnit U{PROJ, NPROW + bs * ST, 16, h, dir, dvh, log_sigmoid(a.in[13][dir * 4 + h]) * L2E, a.in[2] + (size_t)((bs * 2 + dir) * 4 + h) * 32768, nullptr,
                             SB + (size_t)((bs * 64 + h) * 2 + dir) * 32768, 262144, true};
            ret::ret_state_unit(U, lds, tid, lane, wave);
        } else {
            for (int u = bx - 64; u < 512; u += G - 64) { const int b = u >> 4, h = (u >> 2) & 3, dir = (u >> 1) & 1, dvh = u & 1;
                ret::StateUnit U{PROJ, b * PT, 2, h, dir, dvh, log_sigmoid(a.in[13][dir * 4 + h]) * L2E, nullptr, a.out + OUT_STATE + (size_t)((b * 2 + dir) * 4 + h) * 32768,
                                 SB + (size_t)(512 + (b * 4 + h) * 2 + dir) * 32768, 0, false};
                ret::ret_state_unit(U, lds, tid, lane, wave); }
            for (int it = bx - 64; it < 1024; it += G - 64) naive_pool(a, lds, it, tid);
        }
    } SEAM(3);
    if (IN(4)) {
        const float L2E = 1.4426950408889634f; const bf16* SB = (const bf16*)(a.ws + WS_S);
#pragma unroll 1
        for (int u = bx; u < 512; u += G) { int tid = threadIdx.x; asm volatile("" : "+v"(tid)); const int lane = tid & 63; const int row0 = (u >> 2) * 128, h = u & 3; const bf16* Sf; const bf16* Sb;
            if (row0 < NPROW) { const int b = row0 >> 8, c = (row0 >> 7) & 1; const bf16* sl = SB + (size_t)(512 + (b * 4 + h) * 2) * 32768; Sf = c == 1 ? sl : nullptr; Sb = c == 0 ? sl + 32768 : nullptr; }
            else { const int bs = (row0 - NPROW) >> 11, c = ((row0 - NPROW) >> 7) & 15; Sf = SB + (size_t)(((bs * 16 + c) * 4 + h) * 2) * 32768; Sb = Sf + 32768; }
            ret::OutUnit U{PROJ, row0, h, log_sigmoid(a.in[13][h]) * L2E, log_sigmoid(a.in[13][4 + h]) * L2E, Sf, Sb, a.in[14], MIX};
            ret::ret_out_unit(U, lds, (LAS float*)(lds + 132096), tid, lane, wave); }
    } SEAM(4);
    if (IN(5)) { pg8::Gemm g{MIX, (const bf16*)(a.ws + WS_WOUT), M, 1024, MIXW}; pg8::StaticOrder S; S.init(M, 1024, G, bx); pg8::EpiF32 E{OF32, 1024};
        pg8::gemm_phase<pg8::EpiF32, pg8::StaticOrder, true, true>(lds, g, S, E); } SEAM(5);
    if (IN(6)) { for (int m = gw; m < M; m += NGW) resid_row(x_in_row(a, m), OF32 + (size_t)m * DM, ng + 1 * 1024, mod_ptr(a, 0, m, 2), Y + (size_t)m * DM, ng + 2 * 1024, mod_ptr(a, 0, m, 4), mod_ptr(a, 0, m, 3), H + (size_t)m * DM, lane);
        job_wconv_l1(a, lds, lane, wave, gw, NGW); } SEAM(6);
    if (IN(7)) { pg8::Gemm g{H, (const bf16*)(a.ws + WS_WF1_0), M, 2 * DFF, 1024}; pg8::StaticOrder S; S.init(M, 2 * DFF, G, bx); pg8::EpiSwiGLU E{HID, DFF};
        pg8::gemm_phase<pg8::EpiSwiGLU, pg8::StaticOrder, true, true>(lds, g, S, E); } SEAM(7);
    if (IN(8)) { pg8::Gemm g{HID, (const bf16*)(a.ws + WS_WF2_0), M, 1024, DFF}; pg8::StaticOrder S; S.init(M, 1024, G, bx); pg8::EpiF32 E{OF32, 1024};
        pg8::gemm_phase<pg8::EpiF32, pg8::StaticOrder, true, true>(lds, g, S, E); } SEAM(8);
    if (IN(9)) { for (int m = gw; m < M; m += NGW) resid_row(Y + (size_t)m * DM, OF32 + (size_t)m * DM, ng + 3 * 1024, mod_ptr(a, 0, m, 5), Y + (size_t)m * DM, ng + 4 * 1024, mod_ptr(a, 1, m, 1), mod_ptr(a, 1, m, 0), H + (size_t)m * DM, lane);
        job_cache_conv(a, vcu * 512 + tid, G * 512); } SEAM(9);
    if (IN(10)) { pg8::Gemm g{H, (const bf16*)(a.ws + WS_WQKV), M, QKVN, 1024}; pg8::StaticOrder S; S.init(M, QKVN, G, bx); pg8::EpiBf16P E{(bf16*)(a.ws + WS_QKVRAW), QKVN};
        pg8::gemm_phase<pg8::EpiBf16P, pg8::StaticOrder, true, true>(lds, g, S, E); } SEAM(10);
    if (IN(11)) { for (int it = gw; it < M * 12; it += NGW) naive_qkv_post(a, it, lane); } SEAM(11);
    if (IN(12)) {
        bf16* Q = (bf16*)(a.ws + WS_Q); const bf16* Kb = (const bf16*)(a.ws + WS_K); const bf16* Vb = (const bf16*)(a.ws + WS_V);
        for (int it = bx; it < 512; it += G) {
            int qrow, krow, seq, h;
            if (it < 256) { const int b = it >> 3; h = it & 7; qrow = b * PT; krow = b * PT; seq = PT; }
            else { const int u = it - 256, bs = u >> 6, qb = u & 7; h = (u >> 3) & 7; qrow = NPROW + bs * ST + qb * 256; krow = NPROW + bs * KVSEQ_S; seq = KVSEQ_S; }
            bf16* qp = Q + (size_t)qrow * 1024 + h * 128; const size_t ko = (size_t)krow * 256 + (h >> 2) * 128;
            att::attn_dense_body<att::bf16>((const att::bf16*)qp, (const att::bf16*)(Kb + ko), (const att::bf16*)(Vb + ko), qp, seq, (char*)lds_raw);
            __syncthreads();
        }
    } SEAM(12);
    if (IN(13)) { pg8::Gemm g{(const bf16*)(a.ws + WS_Q), (const bf16*)(a.ws + WS_WO), M, 1024, 1024}; pg8::StaticOrder S; S.init(M, 1024, G, bx); pg8::EpiF32 E{OF32, 1024};
        pg8::gemm_phase<pg8::EpiF32, pg8::StaticOrder, true, true>(lds, g, S, E); } SEAM(13);
    if (IN(14)) { for (int m = gw; m < M; m += NGW) resid_row(Y + (size_t)m * DM, OF32 + (size_t)m * DM, ng + 5 * 1024, mod_ptr(a, 1, m, 2), Y + (size_t)m * DM, ng + 6 * 1024, mod_ptr(a, 1, m, 4), mod_ptr(a, 1, m, 3), H + (size_t)m * DM, lane); } SEAM(14);
    if (IN(15)) { pg8::Gemm g{H, (const bf16*)(a.ws + WS_WF1_1), M, 2 * DFF, 1024}; pg8::StaticOrder S; S.init(M, 2 * DFF, G, bx); pg8::EpiSwiGLU E{HID, DFF};
        pg8::gemm_phase<pg8::EpiSwiGLU, pg8::StaticOrder, true, true>(lds, g, S, E); } SEAM(15);
    if (IN(16)) { pg8::Gemm g{HID, (const bf16*)(a.ws + WS_WF2_1), M, 1024, DFF}; pg8::StaticOrder S; S.init(M, 1024, G, bx); pg8::EpiF32 E{OF32, 1024};
        pg8::gemm_phase<pg8::EpiF32, pg8::StaticOrder, true, true>(lds, g, S, E); } SEAM(16);
    if (IN(17)) { for (int m = gw; m < M; m += NGW) resid_row(Y + (size_t)m * DM, OF32 + (size_t)m * DM, ng + 7 * 1024, mod_ptr(a, 1, m, 5), Y + (size_t)m * DM, nullptr, nullptr, nullptr, nullptr, lane); }
#undef IN
#undef SEAM
}

extern "C" void kernel_launch(void* const* d_in, const int* in_sizes, int n_in, void* d_out, int out_size, void* d_ws, size_t ws_size, hipStream_t stream) {
    static int grid = 0;
    if (grid == 0) {
        if (n_in != 22 || in_sizes[0] != NPROW * DM || out_size != 29360128 || ws_size < WS_END) { fprintf(stderr, "kernel_launch: unexpected shapes (n_in %d, in0 %d, out %d, ws %zu)\n", n_in, n_in > 0 ? in_sizes[0] : -1, out_size, ws_size); grid = -1; return; }
        int dev = 0, cus = 0, per_cu = 0;
        if (hipGetDevice(&dev) != hipSuccess || hipDeviceGetAttribute(&cus, hipDeviceAttributeMultiprocessorCount, dev) != hipSuccess) { grid = -1; return; }
        if (hipFuncSetAttribute((const void*)skel_fwd, hipFuncAttributeMaxDynamicSharedMemorySize, LDS_BYTES) != hipSuccess) { fprintf(stderr, "kernel_launch: hipFuncSetAttribute failed\n"); grid = -1; return; }
        if (hipOccupancyMaxActiveBlocksPerMultiprocessor(&per_cu, (const void*)skel_fwd, NWAVES * 64, LDS_BYTES) != hipSuccess || per_cu < 1) { fprintf(stderr, "kernel_launch: occupancy query reports %d blocks per CU\n", per_cu); }
        (void)hipGetLastError();
        grid = cus;
    }
    if (grid < 0) return;
    (void)hipMemsetAsync((char*)d_ws + WS_CTL, 0, CTL_ZERO_BYTES, stream);
    Args a{};
    for (int i = 0; i < 22; ++i) a.in[i] = (const float*)d_in[i];
    a.out = (float*)d_out; a.ws = (unsigned char*)d_ws;
    if (MK_N_LAUNCHES == 1) { a.ph_lo = 0; a.ph_hi = NPHASES; hipLaunchKernelGGL(skel_fwd, dim3(grid), dim3(NWAVES * 64), LDS_BYTES, stream, a); }
    else { for (int p = 0; p < NPHASES; ++p) { a.ph_lo = p; a.ph_hi = p + 1; hipLaunchKernelGGL(skel_fwd, dim3(grid), dim3(NWAVES * 64), LDS_BYTES, stream, a); } }
    const hipError_t le = hipPeekAtLastError();
    if (le != hipSuccess) fprintf(stderr, "kernel_launch: launch failed: %s\n", hipGetErrorName(le));
}
```
